# Optimizing an MI355X kernel written in HIP

```python
import math
import jax, jax.numpy as jnp
from jax import lax
import numpy as np

D_MODEL = 1024
BATCH = 2
SEQ = 16384
DEPTH = 4

N_EVEN = (DEPTH + 1) // 2
N_ODD = DEPTH // 2
N_VRES = max(N_ODD - 1, 0)
N_DIR = 2
RMS_EPS = 1e-6

MIX_WIDTH = D_MODEL
ML_WIDTH = MIX_WIDTH // 2
ML_HEADS = 4
ML_DV = ML_WIDTH // ML_HEADS
ML_DQK = ML_DV // 2
ML_CHUNK = 64
LRU_WIDTH = MIX_WIDTH - ML_WIDTH
LRU_BLOCKS = 8
LRU_BW = LRU_WIDTH // LRU_BLOCKS
LRU_CONV = 4
LRU_C = 8.0
EVEN_SPLIT_SIZES = [ML_HEADS * ML_DQK, ML_HEADS * ML_DQK, ML_WIDTH, ML_WIDTH,
                    N_DIR * 2 * ML_HEADS, LRU_WIDTH, LRU_WIDTH]
IN_EVEN = sum(EVEN_SPLIT_SIZES)
EVEN_SPLITS = [int(s) for s in np.cumsum(EVEN_SPLIT_SIZES)[:-1]]

RW_HEAD = 64
RW_HEADS = D_MODEL // RW_HEAD
RW_DECAY_LORA = 64
RW_AAA_LORA = 64
RW_MV_LORA = 32
RW_GATE_LORA = 160
RW_DECAY_SCALE = math.exp(-0.5)
RW_GN_EPS = 64e-5
RW_NUM_MIX = 6

FFN_HIDDEN = -(-8 * D_MODEL // (3 * 256)) * 256

kernel_name = "hybrid_mlstm_rglru_rwkv7_encoder"


def rmsnorm(x, g, eps=RMS_EPS):
    x32 = x.astype(jnp.float32)
    y = x32 * lax.rsqrt(jnp.mean(x32 * x32, axis=-1, keepdims=True) + eps)
    return (y * g.astype(jnp.float32)).astype(x.dtype)


def swiglu(u, w_gate, w_up, w_down):
    return (jax.nn.silu(u @ w_gate) * (u @ w_up)) @ w_down


def mlstm_chunkwise(q, k, v, i_pre, log_f):
    G, B, H, S, DK = q.shape
    DV = v.shape[-1]
    L = ML_CHUNK
    NC = S // L

    def to_chunks(t):
        t = t.reshape(t.shape[:3] + (NC, L) + t.shape[4:])
        return jnp.moveaxis(t, 3, 0)

    xs = tuple(to_chunks(t) for t in (q, k, v, i_pre, log_f))
    tril = jnp.tril(jnp.ones((L, L), dtype=bool))

    def step(carry, inp):
        C, n, m = carry
        qj, kj, vj, ij, fj = inp
        b = jnp.cumsum(fj, axis=-1)
        g = b[..., -1]
        d_intra = jnp.where(tril, b[..., :, None] - b[..., None, :] + ij[..., None, :], -jnp.inf)
        d_inter = b + m[..., None]
        m_row = jnp.maximum(d_inter, jnp.max(d_intra, axis=-1))
        s = jnp.einsum('gbhjd,gbhsd->gbhjs', qj, kj) * jnp.exp(d_intra - m_row[..., None])
        w_inter = jnp.exp(d_inter - m_row)
        num = (jnp.einsum('gbhjs,gbhsv->gbhjv', s, vj)
               + w_inter[..., None] * jnp.einsum('gbhvd,gbhjd->gbhjv', C, qj))
        den = jnp.sum(s, axis=-1) + w_inter * jnp.einsum('gbhd,gbhjd->gbhj', n, qj)
        h = num / jnp.maximum(jnp.abs(den), jnp.exp(-m_row))[..., None]
        d_state = g[..., None] - b + ij
        m_new = jnp.maximum(g + m, jnp.max(d_state, axis=-1))
        carry_scale = jnp.exp(g + m - m_new)
        w_state = jnp.exp(d_state - m_new[..., None])
        C_new = carry_scale[..., None, None] * C + jnp.einsum('gbhsv,gbhsd->gbhvd', w_state[..., None] * vj, kj)
        n_new = carry_scale[..., None] * n + jnp.einsum('gbhs,gbhsd->gbhd', w_state, kj)
        return (C_new, n_new, m_new), h

    init = (jnp.zeros((G, B, H, DV, DK), jnp.float32),
            jnp.zeros((G, B, H, DK), jnp.float32),
            jnp.zeros((G, B, H), jnp.float32))
    _, h = lax.scan(step, init, xs)
    return jnp.moveaxis(h, 0, 3).reshape(G, B, H, S, DV)


def rglru_branch(xb, gb, conv_w, conv_b, w_a, b_a, w_x, b_x, lam):
    B, S, W = xb.shape
    left = LRU_CONV // 2
    xp = jnp.pad(xb, ((0, 0), (left, LRU_CONV - 1 - left), (0, 0)))
    xc = sum(xp[:, j:j + S] * conv_w[j] for j in range(LRU_CONV)) + conv_b
    xblk = xc.reshape(B, S, LRU_BLOCKS, LRU_BW)
    gate_a = jnp.einsum('bsnc,gncd->gbsnd', xblk, w_a).reshape(N_DIR, B, S, W) + b_a[:, None, None, :]
    gate_x = jnp.einsum('bsnc,gncd->gbsnd', xblk, w_x).reshape(N_DIR, B, S, W) + b_x[:, None, None, :]
    log_a = (-LRU_C * jax.nn.sigmoid(gate_a.astype(jnp.float32))
             * jax.nn.softplus(-lam.astype(jnp.float32))[:, None, None, :])
    a = jnp.exp(log_a)
    u = jnp.sqrt(-jnp.expm1(2.0 * log_a)) * jax.nn.sigmoid(gate_x.astype(jnp.float32)) * xc.astype(jnp.float32)[None]
    a = jnp.stack([a[0], jnp.flip(a[1], axis=1)])
    u = jnp.stack([u[0], jnp.flip(u[1], axis=1)])

    def combine(e1, e2):
        return (e1[0] * e2[0], e2[0] * e1[1] + e2[1])

    _, h = lax.associative_scan(combine, (a, u), axis=2)
    h = h[0] + jnp.flip(h[1], axis=1)
    return (h * jax.nn.gelu(gb.astype(jnp.float32))).astype(xb.dtype)


def even_mixer(u, w_in, w_out, ml_gate_bias, ml_head_gain, conv_w, conv_b, w_a, b_a, w_x, b_x, lam):
    B, S, _ = u.shape
    z = u @ w_in
    q, k, v, o, gates, xb, gb = jnp.split(z, EVEN_SPLITS, axis=-1)
    q = q.reshape(B, S, ML_HEADS, ML_DQK)
    k = k.reshape(B, S, ML_HEADS, ML_DQK) * (ML_DQK ** -0.5)
    v = v.reshape(B, S, ML_HEADS, ML_DV)
    gates = gates.reshape(B, S, N_DIR, 2, ML_HEADS).astype(jnp.float32) + ml_gate_bias.astype(jnp.float32)
    i_pre = gates[..., 0, :]
    log_f = jax.nn.log_sigmoid(gates[..., 1, :])

    def dirs(t):
        return jnp.moveaxis(jnp.stack([t, jnp.flip(t, axis=1)]), 3, 2).astype(jnp.float32)

    def dir_gate(t):
        return jnp.swapaxes(jnp.stack([t[:, :, 0], jnp.flip(t[:, :, 1], axis=1)]), 2, 3)

    h = mlstm_chunkwise(dirs(q), dirs(k), dirs(v), dir_gate(i_pre), dir_gate(log_f))
    h = jnp.swapaxes(h[0] + jnp.flip(h[1], axis=2), 1, 2)
    h = h * lax.rsqrt(jnp.mean(h * h, axis=-1, keepdims=True) + RMS_EPS)
    h = h.reshape(B, S, ML_WIDTH) * ml_head_gain.astype(jnp.float32)
    ml_out = (h * jax.nn.sigmoid(o.astype(jnp.float32))).astype(u.dtype)
    lru_out = rglru_branch(xb, gb, conv_w, conv_b, w_a, b_a, w_x, b_x, lam)
    return jnp.concatenate([ml_out, lru_out], axis=-1) @ w_out


def rwkv7_mixer(u, mu, w_r, w_k, w_v, w_o, w0, wl_a, wl_b, a0, al_a, al_b,
                g_a, g_b, k_k, k_a, r_k, ln_w, ln_b, v_first, v0, vl_a, vl_b):
    B, S, D = u.shape
    H, N = RW_HEADS, RW_HEAD
    prev = jnp.pad(u, ((0, 0), (1, 0), (0, 0)))[:, :-1]
    nxt = jnp.pad(u, ((0, 0), (0, 1), (0, 0)))[:, 1:]
    xx = 0.5 * (prev + nxt) - u
    xr, xw, xk, xv, xa, xg = (u + xx * mu[j] for j in range(RW_NUM_MIX))
    r = xr @ w_r
    k = xk @ w_k
    v = xv @ w_v
    if v0 is None:
        v_first = v
    else:
        v = v + (v_first - v) * jax.nn.sigmoid(v0 + (xv @ vl_a) @ vl_b)
    d_w = w0[:, None, None, :] + jnp.einsum('gbsr,grd->gbsd', jnp.tanh(jnp.einsum('bsd,gdr->gbsr', xw, wl_a)), wl_b)
    w = jnp.exp(-RW_DECAY_SCALE * jax.nn.sigmoid(d_w.astype(jnp.float32)))
    a = jax.nn.sigmoid(a0[:, None, None, :] + jnp.einsum('gbsr,grd->gbsd', jnp.einsum('bsd,gdr->gbsr', xa, al_a), al_b))
    g = jax.nn.sigmoid(xg @ g_a) @ g_b

    def heads(t):
        return t.reshape(t.shape[:-1] + (H, N))

    kk = heads(k * k_k).astype(jnp.float32)
    kk = kk / jnp.maximum(jnp.sqrt(jnp.sum(kk * kk, axis=-1, keepdims=True)), 1e-12)
    k_dir = k[None] * (1.0 + (a - 1.0) * k_a)

    def dir_stack(t):
        return jnp.stack([t, jnp.flip(t, axis=1)])

    def dir_flip(t):
        return jnp.stack([t[0], jnp.flip(t[1], axis=1)])

    seq_in = (dir_stack(heads(r)), dir_flip(heads(w)), dir_flip(heads(k_dir)),
              dir_stack(heads(v)), dir_stack(kk), dir_flip(heads(a)))
    seq_in = tuple(jnp.moveaxis(t.astype(jnp.float32), 2, 0) for t in seq_in)

    def step(state, inp):
        r_t, w_t, k_t, v_t, kk_t, a_t = inp
        sa = jnp.einsum('gbhvk,gbhk->gbhv', state, -kk_t)
        state = (state * w_t[..., None, :] + sa[..., :, None] * (kk_t * a_t)[..., None, :]
                 + v_t[..., :, None] * k_t[..., None, :])
        return state, jnp.einsum('gbhvk,gbhk->gbhv', state, r_t)

    _, wkv = lax.scan(step, jnp.zeros((N_DIR, B, H, N, N), jnp.float32), seq_in)
    wkv = jnp.moveaxis(wkv, 0, 2)
    wkv = wkv[0] + jnp.flip(wkv[1], axis=1)
    mean = jnp.mean(wkv, axis=-1, keepdims=True)
    var = jnp.mean(jnp.square(wkv - mean), axis=-1, keepdims=True)
    gn = ((wkv - mean) * lax.rsqrt(var + RW_GN_EPS)).reshape(B, S, D) * ln_w.astype(jnp.float32) + ln_b.astype(jnp.float32)
    bonus = jnp.sum(heads(r)[None] * heads(k_dir) * r_k, axis=-1, keepdims=True) * heads(v)[None]
    bonus = jnp.sum(bonus, axis=0).reshape(B, S, D)
    y = ((gn + bonus.astype(jnp.float32)) * g.astype(jnp.float32)).astype(u.dtype)
    return y @ w_o, v_first


def setup_inputs(seed: int = 0) -> dict:
    key = jax.random.key(seed)
    keys = jax.random.split(key, 64)
    counter = [0]

    def nxt_key():
        kk = keys[counter[0]]
        counter[0] += 1
        return kk

    def nrm(shape, scale):
        return scale * jax.random.normal(nxt_key(), shape, jnp.float32)

    def unif(shape, lo, hi):
        return jax.random.uniform(nxt_key(), shape, jnp.float32, minval=lo, maxval=hi)

    def gain(shape):
        return 1.0 + nrm(shape, 0.02)

    D, F = D_MODEL, FFN_HIDDEN
    NE, NO, NV = N_EVEN, N_ODD, N_VRES
    ib = nrm((NE, N_DIR, ML_HEADS), 0.1)
    fb = jnp.linspace(3.0, 6.0, ML_HEADS)[None, None, :] + nrm((NE, N_DIR, ML_HEADS), 0.1)
    ml_gate_bias = jnp.stack([ib, fb], axis=2)
    p = unif((NE, N_DIR, LRU_WIDTH), 0.9, 0.999) ** (1.0 / LRU_C)
    lru_lambda = jnp.log(p) - jnp.log1p(-p)
    return {
        "x": nrm((BATCH, SEQ, D), 1.0),
        "norm_mix": gain((DEPTH, D)),
        "norm_ffn": gain((DEPTH, D)),
        "norm_final": gain((D,)),
        "ffn_w_gate": nrm((DEPTH, D, F), D ** -0.5),
        "ffn_w_up": nrm((DEPTH, D, F), D ** -0.5),
        "ffn_w_down": nrm((DEPTH, F, D), F ** -0.5),
        "ev_w_in": nrm((NE, D, IN_EVEN), D ** -0.5),
        "ev_w_out": nrm((NE, MIX_WIDTH, D), MIX_WIDTH ** -0.5),
        "ml_gate_bias": ml_gate_bias,
        "ml_head_gain": gain((NE, ML_WIDTH)),
        "lru_conv_w": nrm((NE, LRU_CONV, LRU_WIDTH), LRU_CONV ** -0.5),
        "lru_conv_b": nrm((NE, LRU_WIDTH), 0.02),
        "lru_w_a": nrm((NE, N_DIR, LRU_BLOCKS, LRU_BW, LRU_BW), LRU_BW ** -0.5),
        "lru_b_a": nrm((NE, N_DIR, LRU_WIDTH), 0.1),
        "lru_w_x": nrm((NE, N_DIR, LRU_BLOCKS, LRU_BW, LRU_BW), LRU_BW ** -0.5),
        "lru_b_x": nrm((NE, N_DIR, LRU_WIDTH), 0.1),
        "lru_lambda": lru_lambda,
        "rw_mu": unif((NO, RW_NUM_MIX, D), 0.0, 1.0),
        "rw_w_r": nrm((NO, D, D), D ** -0.5),
        "rw_w_k": nrm((NO, D, D), D ** -0.5),
        "rw_w_v": nrm((NO, D, D), D ** -0.5),
        "rw_w_o": nrm((NO, D, D), D ** -0.5),
        "rw_w0": jnp.linspace(-6.0, -1.0, D)[None, None, :] + nrm((NO, N_DIR, D), 0.3),
        "rw_w_lora_a": nrm((NO, N_DIR, D, RW_DECAY_LORA), D ** -0.5),
        "rw_w_lora_b": nrm((NO, N_DIR, RW_DECAY_LORA, D), 0.3 * RW_DECAY_LORA ** -0.5),
        "rw_a0": nrm((NO, N_DIR, D), 0.3),
        "rw_a_lora_a": nrm((NO, N_DIR, D, RW_AAA_LORA), D ** -0.5),
        "rw_a_lora_b": nrm((NO, N_DIR, RW_AAA_LORA, D), 0.3 * RW_AAA_LORA ** -0.5),
        "rw_v0": 1.0 + nrm((NV, D), 0.3),
        "rw_v_lora_a": nrm((NV, D, RW_MV_LORA), D ** -0.5),
        "rw_v_lora_b": nrm((NV, RW_MV_LORA, D), 0.3 * RW_MV_LORA ** -0.5),
        "rw_g_lora_a": nrm((NO, D, RW_GATE_LORA), D ** -0.5),
        "rw_g_lora_b": nrm((NO, RW_GATE_LORA, D), RW_GATE_LORA ** -0.5),
        "rw_k_k": 0.85 + nrm((NO, D), 0.02),
        "rw_k_a": 1.0 + nrm((NO, D), 0.02),
        "rw_r_k": nrm((NO, RW_HEADS, RW_HEAD), 0.1),
        "rw_ln_w": gain((NO, D)),
        "rw_ln_b": nrm((NO, D), 0.02),
    }


def reference(x, norm_mix, norm_ffn, norm_final, ffn_w_gate, ffn_w_up, ffn_w_down,
              ev_w_in, ev_w_out, ml_gate_bias, ml_head_gain, lru_conv_w, lru_conv_b,
              lru_w_a, lru_b_a, lru_w_x, lru_b_x, lru_lambda,
              rw_mu, rw_w_r, rw_w_k, rw_w_v, rw_w_o, rw_w0, rw_w_lora_a, rw_w_lora_b,
              rw_a0, rw_a_lora_a, rw_a_lora_b, rw_v0, rw_v_lora_a, rw_v_lora_b,
              rw_g_lora_a, rw_g_lora_b, rw_k_k, rw_k_a, rw_r_k, rw_ln_w, rw_ln_b):
    v_first = None
    for layer in range(DEPTH):
        u = rmsnorm(x, norm_mix[layer])
        if layer % 2 == 0:
            e = layer // 2
            x = x + even_mixer(u, ev_w_in[e], ev_w_out[e], ml_gate_bias[e], ml_head_gain[e],
                               lru_conv_w[e], lru_conv_b[e], lru_w_a[e], lru_b_a[e],
                               lru_w_x[e], lru_b_x[e], lru_lambda[e])
        else:
            o = layer // 2
            if o == 0:
                v0, vl_a, vl_b = None, None, None
            else:
                v0, vl_a, vl_b = rw_v0[o - 1], rw_v_lora_a[o - 1], rw_v_lora_b[o - 1]
            mix, v_first = rwkv7_mixer(u, rw_mu[o], rw_w_r[o], rw_w_k[o], rw_w_v[o], rw_w_o[o],
                                       rw_w0[o], rw_w_lora_a[o], rw_w_lora_b[o],
                                       rw_a0[o], rw_a_lora_a[o], rw_a_lora_b[o],
                                       rw_g_lora_a[o], rw_g_lora_b[o], rw_k_k[o], rw_k_a[o],
                                       rw_r_k[o], rw_ln_w[o], rw_ln_b[o], v_first, v0, vl_a, vl_b)
            x = x + mix
        x = x + swiglu(rmsnorm(x, norm_ffn[layer]), ffn_w_gate[layer], ffn_w_up[layer], ffn_w_down[layer])
    return rmsnorm(x, norm_final)
```

```cpp
#include <hip/hip_runtime.h>
#include <hip/hip_cooperative_groups.h>
#include <cstdio>
namespace cg = cooperative_groups;

#ifndef SINGLE_LAUNCH
#define SINGLE_LAUNCH 1
#endif

#define LAS __attribute__((address_space(3)))
typedef unsigned short bf16_t;
typedef short bf16x8 __attribute__((ext_vector_type(8)));
typedef float f32x4 __attribute__((ext_vector_type(4)));
typedef unsigned u32x4 __attribute__((ext_vector_type(4)));
typedef unsigned u32x2 __attribute__((ext_vector_type(2)));

constexpr int T_ = 32768, S_ = 16384, D_ = 1024, F_ = 2816;
constexpr int LDS_BYTES = 163840;
constexpr size_t MiB = 1ull << 20;
constexpr size_t OFF_WEV = 0;
constexpr size_t OFF_WOD = 16 * MiB;
constexpr size_t OFF_WFFN = 52 * MiB;
constexpr size_t OFF_SS = 69 * MiB;
constexpr size_t OFF_GATES = 71 * MiB;
constexpr size_t OFF_LSUM = 73 * MiB;
constexpr size_t OFF_LCAR = 77 * MiB;
constexpr size_t OFF_BON = 79 * MiB;
constexpr size_t OFF_MLAUX = 83 * MiB;
constexpr size_t OFF_BAR = 86 * MiB;
constexpr size_t OFF_XB = 88 * MiB;
constexpr size_t OFF_VF = 216 * MiB;
constexpr size_t OFF_BIG = 280 * MiB;
constexpr size_t WS_NEED = 504 * MiB;

struct Args { const float* in[39]; float* out; unsigned char* ws; int ph_lo, ph_hi; };

__device__ __forceinline__ int otid() { int t = __builtin_amdgcn_workitem_id_x(); asm volatile("" : "+v"(t)); return t; }
__device__ __forceinline__ int obid() { int b = __builtin_amdgcn_workgroup_id_x(); asm volatile("" : "+s"(b)); return b; }
typedef __bf16 bf16x2_t __attribute__((ext_vector_type(2)));
typedef float f32x2_t __attribute__((ext_vector_type(2)));
__device__ __forceinline__ unsigned cvt_pk_bf16(float lo, float hi) { const f32x2_t v = {lo, hi}; const bf16x2_t b = __builtin_convertvector(v, bf16x2_t); return __builtin_bit_cast(unsigned, b); }
__device__ __forceinline__ bf16_t f2bf(float f) { return (bf16_t)(cvt_pk_bf16(f, 0.f) & 0xffffu); }
__device__ __forceinline__ float bf2f(bf16_t b) { return __uint_as_float(((unsigned)b) << 16); }
__device__ __forceinline__ float bfs2f(short b) { return __uint_as_float(((unsigned)(unsigned short)b) << 16); }
__device__ __forceinline__ float sigm(float x) { return __builtin_amdgcn_rcpf(1.f + __expf(-x)); }
__device__ __forceinline__ float logsig(float x) { return fminf(x, 0.f) - __logf(1.f + __expf(-fabsf(x))); }
__device__ __forceinline__ float tanh_fast(float x) { float e = __expf(2.f * x); return 1.f - 2.f / (e + 1.f); }
__device__ __forceinline__ float gelu_tanh(float x) { return 0.5f * x * (1.f + tanh_fast(0.7978845608f * (x + 0.044715f * x * x * x))); }
template <int CTRL> __device__ __forceinline__ float dppf(float x) { return __builtin_bit_cast(float, __builtin_amdgcn_mov_dpp(__builtin_bit_cast(int, x), CTRL, 0xf, 0xf, true)); }
__device__ __forceinline__ float row16_sum(float x) { x += dppf<0xB1>(x); x += dppf<0x4E>(x); x += dppf<0x141>(x); x += dppf<0x140>(x); return x; }
__device__ __forceinline__ float wave_sum(float x) { for (int o = 32; o >= 1; o >>= 1) x += __shfl_xor(x, o); return x; }
__device__ __forceinline__ float wave_max(float x) { for (int o = 32; o >= 1; o >>= 1) x = fmaxf(x, __shfl_xor(x, o)); return x; }
__device__ __forceinline__ f32x4 mma16(bf16x8 a, bf16x8 b, f32x4 c) { return __builtin_amdgcn_mfma_f32_16x16x32_bf16(a, b, c, 0, 0, 0); }
__device__ __forceinline__ bf16x8 lfrag(const LAS bf16_t* base, int pitch, int row, int k) { return *(const LAS bf16x8*)(base + row * pitch + k); }
__device__ __forceinline__ float rs_from_ss(const float* SS, size_t row) {
    const f32x4* sp = (const f32x4*)(SS + row * 16); const f32x4 s = sp[0] + sp[1] + sp[2] + sp[3];
    return rsqrtf(((s.x + s.y) + (s.z + s.w)) * (1.0f / 1024.0f) + 1e-6f);
}

namespace pg8 {
constexpr int BM = 256, BK = 64, HALF = 128, HTB = HALF * BK * 2, STAGE_BYTES = 8 * HTB, NXCD = 8, WGM = 8;
__device__ __forceinline__ int lds_byte(int r, int c) { const int st = (r >> 4) * 2 + (c >> 5), rr = r & 15, cc = c & 31, ob = rr * 64 + cc * 2; return st * 1024 + (ob ^ (((ob >> 9) & 1) << 5)); }
__device__ __forceinline__ void stage_rc(int b, int& R, int& C) { const int st = b / 1024, sb = b % 1024, swz = sb ^ (((sb >> 9) & 1) << 5); R = (st >> 1) * 16 + swz / 64; C = (st & 1) * 32 + (swz % 64) / 2; }
__device__ __forceinline__ int perm32(int rho) { const int n = rho >> 4, i = rho & 15; return 8 * (i >> 2) + 4 * n + (i & 3); }
struct Unit { int pm, pn; };
struct Gemm { const bf16_t* A; const bf16_t* Bt; int M, N, K; };
struct StaticOrder {
    int nM, nN, nwg, G, c;
    __device__ __forceinline__ void init(int M, int N, int G_, int c_) { nM = M / BM; nN = N / BM; nwg = nM * nN; G = G_; c = c_; }
    __device__ bool next(int i, Unit& u) const {
        const long L = (long)i * G + c; if (L >= nwg) return false;
        int wgid = (int)L; { const int q = nwg / NXCD, r = nwg % NXCD, xcd = wgid % NXCD, off = wgid / NXCD; wgid = (xcd < r ? xcd * (q + 1) : r * (q + 1) + (xcd - r) * q) + off; }
        const int nig = WGM * nN, gid = wgid / nig, fm = gid * WGM, gsz = (nM - fm) < WGM ? (nM - fm) : WGM;
        u.pm = fm + ((wgid % nig) % gsz); u.pn = (wgid % nig) / gsz; return true;
    }
};

struct EpiZ {
    static constexpr bool PERM = true;
    bf16_t* Zp; const float* SS;
    __device__ __forceinline__ void operator()(const f32x4 (&acc)[2][2][4][2], const Unit& u, int wr, int wc, int fr, int fq) const {
        const int row0 = u.pm * BM + wr * 64 + fr, col0 = u.pn * BM + wc * 32 + 8 * fq;
#pragma unroll
        for (int ai = 0; ai < 2; ++ai)
#pragma unroll
            for (int m = 0; m < 4; ++m) { const size_t row = row0 + ai * HALF + m * 16; const float rs = rs_from_ss(SS, row); bf16_t* rowp = Zp + row * 2560 + col0;
#pragma unroll
                for (int bj = 0; bj < 2; ++bj) { const f32x4 v0 = acc[ai][bj][m][0] * rs, v1 = acc[ai][bj][m][1] * rs;
                    u32x4 w; w.x = cvt_pk_bf16(v0[0], v0[1]); w.y = cvt_pk_bf16(v0[2], v0[3]); w.z = cvt_pk_bf16(v1[0], v1[1]); w.w = cvt_pk_bf16(v1[2], v1[3]);
                    *(u32x4*)(rowp + bj * HALF) = w; }
                asm volatile("" ::: "memory"); }
    }
};
struct EpiSwi {
    static constexpr bool PERM = true;
    bf16_t* Hp; const float* SS;
    __device__ __forceinline__ void operator()(const f32x4 (&acc)[2][2][4][2], const Unit& u, int wr, int wc, int fr, int fq) const {
        const int row0 = u.pm * BM + wr * 64 + fr, col0 = u.pn * HALF + wc * 32 + 8 * fq;
#pragma unroll
        for (int ai = 0; ai < 2; ++ai)
#pragma unroll
            for (int m = 0; m < 4; ++m) { const size_t row = row0 + ai * HALF + m * 16; const float rs = rs_from_ss(SS, row);
                float hv[8];
#pragma unroll
                for (int n = 0; n < 2; ++n)
#pragma unroll
                    for (int j = 0; j < 4; ++j) { const float g = acc[ai][0][m][n][j] * rs, up = acc[ai][1][m][n][j] * rs; hv[n * 4 + j] = g * sigm(g) * up; }
                u32x4 w; w.x = cvt_pk_bf16(hv[0], hv[1]); w.y = cvt_pk_bf16(hv[2], hv[3]); w.z = cvt_pk_bf16(hv[4], hv[5]); w.w = cvt_pk_bf16(hv[6], hv[7]);
                *(u32x4*)(Hp + row * 2816 + col0) = w;
                asm volatile("" ::: "memory"); }
    }
};
struct EpiRKV {
    static constexpr bool PERM = true;
    bf16_t* Rp;
    __device__ __forceinline__ void operator()(const f32x4 (&acc)[2][2][4][2], const Unit& u, int wr, int wc, int fr, int fq) const {
        const int pn = u.pn; const int row0 = u.pm * BM + wr * 64 + fr;
        const bool lora = pn >= 12; const int sel = lora ? 3 : (pn >> 2); const int ld = lora ? 512 : 1024; const int colt = lora ? (pn - 12) * 256 : (pn & 3) * 256;
        bf16_t* base = Rp + (size_t)sel * 33554432;
        const int col0 = colt + wc * 32 + 8 * fq;
#pragma unroll
        for (int ai = 0; ai < 2; ++ai)
#pragma unroll
            for (int m = 0; m < 4; ++m) { const size_t row = row0 + ai * HALF + m * 16; bf16_t* rowp = base + row * ld + col0;
#pragma unroll
                for (int bj = 0; bj < 2; ++bj) { f32x4 v0 = acc[ai][bj][m][0], v1 = acc[ai][bj][m][1];
                    if (lora) { const int c = col0 + bj * HALF; const int mode = c < 128 ? 1 : (c < 256 ? 0 : (c < 416 ? 2 : 0));
                        if (mode == 1) {
#pragma unroll
                            for (int j = 0; j < 4; ++j) { v0[j] = tanh_fast(v0[j]); v1[j] = tanh_fast(v1[j]); } }
                        else if (mode == 2) {
#pragma unroll
                            for (int j = 0; j < 4; ++j) { v0[j] = sigm(v0[j]); v1[j] = sigm(v1[j]); } } }
                    u32x4 w; w.x = cvt_pk_bf16(v0[0], v0[1]); w.y = cvt_pk_bf16(v0[2], v0[3]); w.z = cvt_pk_bf16(v1[0], v1[1]); w.w = cvt_pk_bf16(v1[2], v1[3]);
                    *(u32x4*)(rowp + bj * HALF) = w; }
                asm volatile("" ::: "memory"); }
    }
};
struct EpiRes {
    static constexpr bool PERM = false;
    float* X; bf16_t* XB; float* SS;
    __device__ __forceinline__ void operator()(const f32x4 (&acc)[2][2][4][2], const Unit& u, int wr, int wc, int fr, int fq) const {
        const int row0 = u.pm * BM + wr * 64 + fr, col0 = u.pn * BM + wc * 32 + 4 * fq;
#pragma unroll
        for (int ai = 0; ai < 2; ++ai)
#pragma unroll
            for (int m = 0; m < 4; ++m) { const size_t row = row0 + ai * HALF + m * 16; float* xr = X + row * 1024 + col0; bf16_t* br = XB + row * 1024 + col0; float ss = 0.f;
#pragma unroll
                for (int bj = 0; bj < 2; ++bj)
#pragma unroll
                    for (int n = 0; n < 2; ++n) { f32x4 x = *(const f32x4*)(xr + bj * HALF + n * 16); x += acc[ai][bj][m][n]; *(f32x4*)(xr + bj * HALF + n * 16) = x;
                        u32x2 w; w.x = cvt_pk_bf16(x[0], x[1]); w.y = cvt_pk_bf16(x[2], x[3]); *(u32x2*)(br + bj * HALF + n * 16) = w;
                        ss += (x[0] * x[0] + x[1] * x[1]) + (x[2] * x[2] + x[3] * x[3]); }
                ss += __shfl_xor(ss, 16); ss += __shfl_xor(ss, 32);
                if (fq == 0) SS[row * 16 + u.pn * 4 + wc] = ss;
                asm volatile("" ::: "memory"); }
    }
};

template <class Epi>
__device__ __forceinline__ void gemm_phase(LAS unsigned char* lds, const Gemm g, const StaticOrder& S, const Epi& E) {
    const int tid = otid(), wid = __builtin_amdgcn_readfirstlane(tid >> 6), lane = tid & 63, wr = wid >> 2, wc = wid & 3, fr = lane & 15, fq = lane >> 4;
    const int K = g.K, nt = K / BK;
    unsigned voffA[2], voffB[2];
#pragma unroll
    for (int i = 0; i < 2; ++i) { int R, C; stage_rc(tid * 16 + i * 8192, R, C); const int Rb = Epi::PERM ? ((R & ~31) + perm32(R & 31)) : R;
        voffA[i] = (unsigned)(R * K + C) * 2u; voffB[i] = (unsigned)(Rb * K + C) * 2u; }
    const size_t kstep = (size_t)(BK * 2);
    const size_t hstep = (size_t)HALF * K * 2;
    const size_t tstep = 2 * hstep;
    const unsigned ldsw = (unsigned)wid * 1024u;
    const int aoff = lds_byte(wr * 64 + fr, fq * 8), boff = lds_byte(wc * 32 + fr, fq * 8);
#define PG8_SA(b, h) (((b) * 2 + (h)) * HTB)
#define PG8_SB(b, h) ((4 + (b) * 2 + (h)) * HTB)
#define PG8_STAGE(bufoff, gbase, voff) do { _Pragma("unroll") for (int _i = 0; _i < 2; ++_i) \
        __builtin_amdgcn_global_load_lds((const unsigned*)((const char*)(gbase) + (voff)[_i]), (LAS unsigned*)(lds + (bufoff) + ldsw + _i * 8192), 16, 0, 0); } while (0)
#define PG8_LDA(dst, b, h) do { _Pragma("unroll") for (int m = 0; m < 4; ++m) _Pragma("unroll") for (int k = 0; k < 2; ++k) dst[m][k] = *(const LAS bf16x8*)(lds + PG8_SA(b, h) + aoff + m * 2048 + k * 1024); } while (0)
#define PG8_LDB(dst, b, h) do { _Pragma("unroll") for (int n = 0; n < 2; ++n) _Pragma("unroll") for (int k = 0; k < 2; ++k) dst[n][k] = *(const LAS bf16x8*)(lds + PG8_SB(b, h) + boff + n * 2048 + k * 1024); } while (0)
#define PG8_MMA(ai, bj, At, Bt) do { __builtin_amdgcn_s_setprio(1); _Pragma("unroll") for (int m = 0; m < 4; ++m) _Pragma("unroll") for (int n = 0; n < 2; ++n) _Pragma("unroll") for (int k = 0; k < 2; ++k) \
        acc[ai][bj][m][n] = __builtin_amdgcn_mfma_f32_16x16x32_bf16(Bt[n][k], At[m][k], acc[ai][bj][m][n], 0, 0, 0); __builtin_amdgcn_s_setprio(0); } while (0)
#define PG8_WAIT_V(n) asm volatile("s_waitcnt vmcnt(" #n ")" ::: "memory")
#define PG8_WAIT_L(n) asm volatile("s_waitcnt lgkmcnt(" #n ")" ::: "memory")
#define PG8_BAR __builtin_amdgcn_s_barrier()
#define PG8_SCHED __builtin_amdgcn_sched_barrier(0)
    Unit cur, nxt; int ui = 0;
    if (!S.next(0, cur)) return;
    f32x4 acc[2][2][4][2];
#pragma unroll
    for (int a = 0; a < 2; ++a)
#pragma unroll
        for (int b = 0; b < 2; ++b)
#pragma unroll
            for (int m = 0; m < 4; ++m)
#pragma unroll
                for (int n = 0; n < 2; ++n) acc[a][b][m][n] = (f32x4){0.f, 0.f, 0.f, 0.f};
    bf16x8 At[4][2], B0[2][2], B1[2][2];
    const char* cA = (const char*)g.A + (size_t)cur.pm * tstep; const char* cB = (const char*)g.Bt + (size_t)cur.pn * tstep;
    PG8_STAGE(PG8_SB(0, 0), cB, voffB); PG8_STAGE(PG8_SA(0, 0), cA, voffA); PG8_STAGE(PG8_SB(0, 1), cB + hstep, voffB); PG8_STAGE(PG8_SA(0, 1), cA + hstep, voffA);
    if (wr == 1) PG8_BAR;
    PG8_WAIT_V(4); PG8_BAR;
    PG8_STAGE(PG8_SB(1, 0), cB + kstep, voffB); PG8_STAGE(PG8_SA(1, 0), cA + kstep, voffA); PG8_STAGE(PG8_SB(1, 1), cB + hstep + kstep, voffB);
    PG8_WAIT_V(6); PG8_BAR;
    for (;;) {
        const bool has_next = S.next(ui + 1, nxt);
        const char* nA = has_next ? (const char*)g.A + (size_t)nxt.pm * tstep : cA; const char* nB = has_next ? (const char*)g.Bt + (size_t)nxt.pn * tstep : cB;
        for (int t = 0; t < nt; t += 2) {
            const bool last = (t == nt - 2);
            const char* a1 = cA + (size_t)(t + 1) * kstep;
            const char* a2 = last ? nA : cA + (size_t)(t + 2) * kstep; const char* b2 = last ? nB : cB + (size_t)(t + 2) * kstep;
            const char* a3 = a2 + kstep; const char* b3 = b2 + kstep;
            PG8_LDB(B0, 0, 0); PG8_SCHED; PG8_LDA(At, 0, 0); PG8_STAGE(PG8_SA(1, 1), a1 + hstep, voffA);
            PG8_WAIT_L(8); PG8_BAR; PG8_WAIT_L(0); PG8_MMA(0, 0, At, B0); PG8_BAR; PG8_SCHED;
            PG8_LDB(B1, 0, 1); PG8_STAGE(PG8_SB(0, 0), b2, voffB);
            PG8_BAR; PG8_WAIT_L(0); PG8_MMA(0, 1, At, B1); PG8_BAR;
            PG8_LDA(At, 0, 1); PG8_STAGE(PG8_SA(0, 0), a2, voffA);
            PG8_BAR; PG8_WAIT_L(0); PG8_MMA(1, 0, At, B0); PG8_BAR; PG8_SCHED;
            PG8_STAGE(PG8_SB(0, 1), b2 + hstep, voffB);
            PG8_WAIT_V(6); PG8_BAR; PG8_MMA(1, 1, At, B1); PG8_BAR;
            PG8_LDB(B0, 1, 0); PG8_SCHED; PG8_LDA(At, 1, 0); PG8_STAGE(PG8_SA(0, 1), a2 + hstep, voffA);
            PG8_WAIT_L(8); PG8_BAR; PG8_WAIT_L(0); PG8_MMA(0, 0, At, B0); PG8_BAR; PG8_SCHED;
            PG8_LDB(B1, 1, 1); PG8_STAGE(PG8_SB(1, 0), b3, voffB);
            PG8_BAR; PG8_WAIT_L(0); PG8_MMA(0, 1, At, B1); PG8_BAR;
            PG8_LDA(At, 1, 1); PG8_STAGE(PG8_SA(1, 0), a3, voffA);
            PG8_BAR; PG8_WAIT_L(0); PG8_MMA(1, 0, At, B0); PG8_BAR; PG8_SCHED;
            PG8_STAGE(PG8_SB(1, 1), b3 + hstep, voffB);
            PG8_WAIT_V(6); PG8_BAR; PG8_MMA(1, 1, At, B1); PG8_BAR;
        }
        E(acc, cur, wr, wc, fr, fq);
        if (!has_next) break;
#pragma unroll
        for (int a = 0; a < 2; ++a)
#pragma unroll
            for (int b = 0; b < 2; ++b)
#pragma unroll
                for (int m = 0; m < 4; ++m)
#pragma unroll
                    for (int n = 0; n < 2; ++n) acc[a][b][m][n] = (f32x4){0.f, 0.f, 0.f, 0.f};
        cur = nxt; cA = nA; cB = nB; ++ui;
    }
    PG8_WAIT_V(0);
    if (wr == 0) PG8_BAR;
    PG8_BAR;
#undef PG8_SA
#undef PG8_SB
#undef PG8_STAGE
#undef PG8_LDA
#undef PG8_LDB
#undef PG8_MMA
#undef PG8_WAIT_V
#undef PG8_WAIT_L
#undef PG8_BAR
#undef PG8_SCHED
}
}

struct Job { const float* in; int ld_in, K, ncols; bf16_t* out; int ld_out; const float* scale; float mul; int nb; size_t ibs, obs; };
__device__ __forceinline__ void run_job(LAS float* tl, const Job j, int& tile_base) {
    const int tc_n = (j.ncols + 63) >> 6, tk_n = (j.K + 63) >> 6, per = tc_n * tk_n, total = j.nb * per, G = gridDim.x;
    const int start = (obid() - tile_base % G + G) % G;
    const int tid = otid();
    for (int t0 = start; t0 < total; t0 += 4 * G) {
        f32x4 v[4][2];
#pragma unroll
        for (int u = 0; u < 4; ++u) { const int t = t0 + u * G;
#pragma unroll
            for (int hh = 0; hh < 2; ++hh) { v[u][hh] = (f32x4){0.f, 0.f, 0.f, 0.f};
                if (t < total) { const int bi = t / per, r = t % per, tc = r / tk_n, tk = r % tk_n; const int idx = tid + 512 * hh, kk = idx >> 4, cc = (idx & 15) * 4, k = tk * 64 + kk, c = tc * 64 + cc;
                    if (j.in != nullptr && k < j.K && c < j.ncols) { v[u][hh] = *(const f32x4*)(j.in + bi * j.ibs + (size_t)k * j.ld_in + c) * j.mul; if (j.scale) v[u][hh] *= j.scale[k]; } } } }
#pragma unroll
        for (int u = 0; u < 4; ++u)
#pragma unroll
            for (int hh = 0; hh < 2; ++hh) { const int idx = tid + 512 * hh, kk = idx >> 4, cc = (idx & 15) * 4; LAS float* tp = tl + u * 4160 + kk * 65 + cc;
                tp[0] = v[u][hh][0]; tp[1] = v[u][hh][1]; tp[2] = v[u][hh][2]; tp[3] = v[u][hh][3]; }
        __syncthreads();
#pragma unroll
        for (int u = 0; u < 4; ++u) { const int t = t0 + u * G;
            if (t < total) { const int bi = t / per, r = t % per, tc = r / tk_n, tk = r % tk_n; bf16_t* out = j.out + bi * j.obs;
                for (int idx = tid; idx < 2048; idx += 512) { const int cc = idx >> 5, kp = idx & 31, k = tk * 64 + 2 * kp, c = tc * 64 + cc;
                    if (c < j.ncols && k < j.K) *(unsigned*)(out + (size_t)c * j.ld_out + k) = cvt_pk_bf16(tl[u * 4160 + (2 * kp) * 65 + cc], tl[u * 4160 + (2 * kp + 1) * 65 + cc]); } } }
        __syncthreads();
    }
    tile_base += total;
}
#define SETJ(in_, ld_in_, K_, ncols_, out_, ld_out_, scale_, mul_, nb_, ibs_, obs_) do { jb.in = (in_); jb.ld_in = (ld_in_); jb.K = (K_); jb.ncols = (ncols_); jb.out = (out_); jb.ld_out = (ld_out_); \
        jb.scale = (scale_); jb.mul = (mul_); jb.nb = (nb_); jb.ibs = (ibs_); jb.obs = (obs_); } while (0)
__device__ __forceinline__ void cvt_mixer_weights(LAS float* tl, const Args& a) {
    int tb = 0; unsigned char* ws = a.ws; const float* nfp = nullptr; const size_t MM = (size_t)1024 * 1024;
    for (int jid = 0; jid < 16 + 44; ++jid) {
        Job jb; bool ok = true;
        if (jid < 16) {
            const int e = jid >> 3, k = jid & 7;
            bf16_t* WinT = (bf16_t*)(ws + OFF_WEV + e * 8 * MiB); bf16_t* WgT = WinT + 5 * MiB / 2; bf16_t* WoutT = (bf16_t*)(ws + OFF_WEV + e * 8 * MiB + 5 * MiB + MiB / 4); bf16_t* LWT = (bf16_t*)(ws + OFF_WEV + e * 8 * MiB + 7 * MiB + MiB / 4);
            const float* win = a.in[7] + (size_t)e * 1024 * 2576; const float* nm = a.in[1] + (size_t)(2 * e) * 1024;
            if (k == 0) SETJ(win, 2576, 1024, 256, WinT, 1024, nm, 1.f, 1, 0, 0);
            else if (k == 1) SETJ(win + 256, 2576, 1024, 256, WinT + 256 * 1024, 1024, nm, 0.125f, 1, 0, 0);
            else if (k == 2) SETJ(win + 512, 2576, 1024, 1024, WinT + 512 * 1024, 1024, nm, 1.f, 1, 0, 0);
            else if (k == 3) SETJ(win + 1552, 2576, 1024, 1024, WinT + 1536 * 1024, 1024, nm, 1.f, 1, 0, 0);
            else if (k == 4) SETJ(win + 1536, 2576, 1024, 16, WgT, 1024, nm, 1.f, 1, 0, 0);
            else if (k == 5) SETJ(a.in[8] + (size_t)e * MM, 1024, 1024, 1024, WoutT, 1024, nfp, 1.f, 1, 0, 0);
            else if (k == 6) SETJ(a.in[13] + (size_t)e * 16 * 4096, 64, 64, 64, LWT, 64, nfp, 1.f, 16, 4096, 4096);
            else SETJ(a.in[15] + (size_t)e * 16 * 4096, 64, 64, 64, LWT + 16 * 4096, 64, nfp, 1.f, 16, 4096, 4096);
        } else {
            const int o = (jid - 16) / 22, k = (jid - 16) % 22;
            unsigned char* wb = ws + OFF_WOD + o * 18 * MiB;
            bf16_t* Wrkv = (bf16_t*)wb; bf16_t* WoT = (bf16_t*)(wb + 14 * MiB); bf16_t* wlbT = (bf16_t*)(wb + 16 * MiB); bf16_t* albT = (bf16_t*)(wb + 16 * MiB + MiB / 4);
            bf16_t* gbT = (bf16_t*)(wb + 16 * MiB + MiB / 2); bf16_t* vlbT = (bf16_t*)(wb + 16 * MiB + 7 * MiB / 8);
            const float* mu = a.in[18] + (size_t)o * 6 * 1024;
            const int half = k & 1; const size_t koff = half ? 1024 : 0;
            if (k < 6) { const int w = k >> 1; const float* src = (w == 0 ? a.in[19] : (w == 1 ? a.in[20] : a.in[21])) + o * MM; const int mi = w == 0 ? 0 : (w == 1 ? 2 : 3);
                SETJ(src, 1024, 1024, 1024, Wrkv + (size_t)(1024 * w) * 2048 + koff, 2048, half ? mu + mi * 1024 : nfp, 1.f, 1, 0, 0); }
            else if (k < 8) SETJ(a.in[24] + (size_t)o * 2 * 65536, 64, 1024, 64, Wrkv + (size_t)3072 * 2048 + koff, 2048, half ? mu + 1 * 1024 : nfp, 1.f, 2, 65536, (size_t)64 * 2048);
            else if (k < 10) SETJ(a.in[27] + (size_t)o * 2 * 65536, 64, 1024, 64, Wrkv + (size_t)3200 * 2048 + koff, 2048, half ? mu + 4 * 1024 : nfp, 1.f, 2, 65536, (size_t)64 * 2048);
            else if (k < 12) SETJ(a.in[32] + (size_t)o * 1024 * 160, 160, 1024, 160, Wrkv + (size_t)3328 * 2048 + koff, 2048, half ? mu + 5 * 1024 : nfp, 1.f, 1, 0, 0);
            else if (k < 14) { if (o == 1) SETJ(a.in[30], 32, 1024, 32, Wrkv + (size_t)3488 * 2048 + koff, 2048, half ? mu + 3 * 1024 : nfp, 1.f, 1, 0, 0);
                               else SETJ(nfp, 0, 1024, 32, Wrkv + (size_t)3488 * 2048 + koff, 2048, nfp, 1.f, 1, 0, 0); }
            else if (k == 14) SETJ(nfp, 0, 2048, 64, Wrkv + (size_t)3520 * 2048, 2048, nfp, 1.f, 1, 0, 0);
            else if (k == 15) SETJ(a.in[22] + o * MM, 1024, 1024, 1024, WoT, 1024, nfp, 1.f, 1, 0, 0);
            else if (k == 16) SETJ(a.in[25] + (size_t)o * 2 * 65536, 1024, 64, 1024, wlbT, 64, nfp, 1.f, 2, 65536, 65536);
            else if (k == 17) SETJ(a.in[28] + (size_t)o * 2 * 65536, 1024, 64, 1024, albT, 64, nfp, 1.f, 2, 65536, 65536);
            else if (k == 18) SETJ(a.in[33] + (size_t)o * 160 * 1024, 1024, 160, 1024, gbT, 160, nfp, 1.f, 1, 0, 0);
            else if (k == 19 && o == 1) SETJ(a.in[31], 1024, 32, 1024, vlbT, 32, nfp, 1.f, 1, 0, 0);
            else ok = false;
        }
        if (ok) run_job(tl, jb, tb);
    }
}
__device__ __forceinline__ void cvt_ffn_weights(LAS float* tl, const Args& a, int Lr) {
    int tb = 0; unsigned char* ws = a.ws; const float* nfp = nullptr;
    bf16_t* WguT = (bf16_t*)(ws + OFF_WFFN); bf16_t* WdT = (bf16_t*)(ws + OFF_WFFN + 11 * MiB);
    const float* nf = a.in[2] + (size_t)Lr * 1024; const size_t WF = (size_t)1024 * 2816;
    for (int k = 0; k < 3; ++k) { Job jb;
        if (k == 0) SETJ(a.in[4] + Lr * WF, 2816, 1024, 128, WguT, 1024, nf, 1.f, 22, 128, (size_t)256 * 1024);
        else if (k == 1) SETJ(a.in[5] + Lr * WF, 2816, 1024, 128, WguT + 128 * 1024, 1024, nf, 1.f, 22, 128, (size_t)256 * 1024);
        else SETJ(a.in[6] + Lr * WF, 1024, 2816, 1024, WdT, 2816, nfp, 1.f, 1, 0, 0);
        run_job(tl, jb, tb); }
}

__device__ __forceinline__ void p0_rows(const float* x, float* X, bf16_t* XB, float* SS) {
    const int wid = otid() >> 6, lane = otid() & 63;
#pragma unroll 2
    for (int row = obid() * 8 + wid; row < T_; row += gridDim.x * 8) {
        const float* xr = x + (size_t)row * 1024; float ss = 0.f;
#pragma unroll
        for (int i = 0; i < 4; ++i) { const int col = i * 256 + lane * 4; const f32x4 v = *(const f32x4*)(xr + col); *(f32x4*)(X + (size_t)row * 1024 + col) = v;
            u32x2 w; w.x = cvt_pk_bf16(v[0], v[1]); w.y = cvt_pk_bf16(v[2], v[3]); *(u32x2*)(XB + (size_t)row * 1024 + col) = w;
            ss += (v[0] * v[0] + v[1] * v[1]) + (v[2] * v[2] + v[3] * v[3]); }
        ss = wave_sum(ss);
        if (lane < 16) SS[(size_t)row * 16 + lane] = lane == 0 ? ss : 0.f;
    }
}
__device__ __forceinline__ void final_rows(float* X, const float* SS, const float* nf) {
    const int wid = otid() >> 6, lane = otid() & 63;
#pragma unroll 2
    for (int row = obid() * 8 + wid; row < T_; row += gridDim.x * 8) {
        const float rs = rs_from_ss(SS, row);
#pragma unroll
        for (int i = 0; i < 4; ++i) { const int col = i * 256 + lane * 4; f32x4 v = *(const f32x4*)(X + (size_t)row * 1024 + col); const f32x4 g = *(const f32x4*)(nf + col);
            v = v * rs * g; *(f32x4*)(X + (size_t)row * 1024 + col) = v; }
    }
}

__device__ __forceinline__ void gates_gemm(const bf16_t* XB, const bf16_t* WgT, const float* SS, const float* bias, float* GATES) {
    const int wid = otid() >> 6, lane = otid() & 63, fr = lane & 15, fq = lane >> 4;
    for (int rt = obid() * 8 + wid; rt < T_ / 16; rt += gridDim.x * 8) {
        const size_t row = (size_t)rt * 16 + fr; f32x4 acc = {0.f, 0.f, 0.f, 0.f};
        const bf16_t* xr = XB + row * 1024 + 8 * fq; const bf16_t* wr = WgT + fr * 1024 + 8 * fq;
#pragma unroll 8
        for (int kk = 0; kk < 32; ++kk) { const bf16x8 xa = *(const bf16x8*)(xr + kk * 32), wb = *(const bf16x8*)(wr + kk * 32); acc = mma16(wb, xa, acc); }
        const float rs = rs_from_ss(SS, row); const f32x4 bv = *(const f32x4*)(bias + 4 * fq);
        *(f32x4*)(GATES + row * 16 + 4 * fq) = acc * rs + bv;
    }
}

__device__ __forceinline__ void ml_local(LAS unsigned char* L, const bf16_t* Z, const float* GATES, bf16_t* MLC, float* MLDN, float* MLG, float* MLA) {
    LAS bf16_t* Kt = (LAS bf16_t*)L; LAS bf16_t* Vt = Kt + 64 * 72; LAS float* wst = (LAS float*)(Vt + 128 * 72);
    const int tid = otid(), wid = tid >> 6, lane = tid & 63, fr = lane & 15, fq = lane >> 4;
    for (int item = obid(); item < 4096; item += gridDim.x) {
        const int chain = item >> 8, j = item & 255, g = chain >> 3, b = (chain >> 2) & 1, h = chain & 3;
        if (wid == 0) { const int s = 64 * j + lane, t = g ? (S_ - 1 - s) : s; const size_t row = (size_t)b * S_ + t;
            const float fpre = GATES[row * 16 + g * 8 + 4 + h], ipre = GATES[row * 16 + g * 8 + h];
            float bc = logsig(fpre);
            for (int o = 1; o < 64; o <<= 1) { const float v = __shfl_up(bc, o); if (lane >= o) bc += v; }
            const float gt = __shfl(bc, 63); const float ds = gt - bc + ipre; const float mx = wave_max(ds);
            wst[lane] = __expf(ds - mx);
            if (lane == 0) { MLG[item] = gt; MLA[item] = mx; } }
        __syncthreads();
        { const int i = tid >> 3, sg = tid & 7; const int s = 64 * j + i, t = g ? (S_ - 1 - s) : s; const bf16_t* zr = Z + ((size_t)b * S_ + t) * 2560;
            const bf16x8 kv = *(const bf16x8*)(zr + 256 + h * 64 + sg * 8);
#pragma unroll
            for (int e = 0; e < 8; ++e) Kt[(sg * 8 + e) * 72 + i] = (bf16_t)kv[e];
            const float w = wst[i];
#pragma unroll
            for (int hh = 0; hh < 2; ++hh) { const bf16x8 vv = *(const bf16x8*)(zr + 512 + h * 128 + (sg + 8 * hh) * 8);
#pragma unroll
                for (int e = 0; e < 8; ++e) Vt[((sg + 8 * hh) * 8 + e) * 72 + i] = f2bf(bfs2f(vv[e]) * w); } }
        __syncthreads();
        if (tid < 64) { float s = 0.f; for (int i = 0; i < 64; ++i) s += wst[i] * bf2f(Kt[tid * 72 + i]); MLDN[(size_t)item * 64 + tid] = s; }
        f32x4 acc[4];
#pragma unroll
        for (int td = 0; td < 4; ++td) acc[td] = (f32x4){0.f, 0.f, 0.f, 0.f};
#pragma unroll
        for (int kk = 0; kk < 2; ++kk) { const bf16x8 bv = lfrag(Vt, 72, wid * 16 + fr, kk * 32 + 8 * fq);
#pragma unroll
            for (int td = 0; td < 4; ++td) acc[td] = mma16(lfrag(Kt, 72, td * 16 + fr, kk * 32 + 8 * fq), bv, acc[td]); }
        bf16_t* out = MLC + (size_t)item * 8192 + (wid * 16 + fr) * 64 + 4 * fq;
#pragma unroll
        for (int td = 0; td < 4; ++td) { u32x2 w; w.x = cvt_pk_bf16(acc[td][0], acc[td][1]); w.y = cvt_pk_bf16(acc[td][2], acc[td][3]); *(u32x2*)(out + td * 16) = w; }
        __syncthreads();
    }
}
__device__ __forceinline__ void ml_combine(bf16_t* MLC, float* MLDN, const float* MLG, const float* MLA, float* MLM) {
    for (int id = obid() * 512 + otid(); id < 131072; id += gridDim.x * 512) {
        const int chain = id >> 13, el = id & 8191; const bool don = el < 64;
        float C = 0.f, m = 0.f, n = 0.f;
        for (int j0 = 0; j0 < 256; j0 += 16) {
            float d[16];
#pragma unroll
            for (int u = 0; u < 16; ++u) d[u] = bf2f(MLC[(size_t)(chain * 256 + j0 + u) * 8192 + el]);
#pragma unroll
            for (int u = 0; u < 16; ++u) { const int item = chain * 256 + j0 + u; const float g = MLG[item], am = MLA[item];
                MLC[(size_t)item * 8192 + el] = f2bf(C);
                float dn = 0.f; if (don) { dn = MLDN[(size_t)item * 64 + el]; MLDN[(size_t)item * 64 + el] = n; }
                if (el == 0) MLM[item] = m;
                const float mn = fmaxf(g + m, am), sc = __expf(g + m - mn), sd = __expf(am - mn);
                C = sc * C + sd * d[u]; n = sc * n + sd * dn; m = mn; }
        }
    }
}
__device__ __forceinline__ void ml_out(LAS unsigned char* L, const bf16_t* Z, const float* GATES, const bf16_t* MLC, const float* MLDN, const float* MLM, const float* gain, bf16_t* Y) {
    LAS bf16_t* Qs = (LAS bf16_t*)L; LAS bf16_t* Ks = Qs + 64 * 72; LAS bf16_t* Vt = Ks + 64 * 72; LAS bf16_t* Cs = Vt + 128 * 72; LAS bf16_t* Sm = Cs + 128 * 72; LAS bf16_t* Qw = Sm + 64 * 72;
    LAS float* Hacc = (LAS float*)(Qw + 64 * 72); LAS float* fl = Hacc + 64 * 132;
    LAS float* bcum = fl; LAS float* et = fl + 64; LAS float* Ms = fl + 128; LAS float* wint = fl + 192; LAS float* denp = fl + 256; LAS float* deni = fl + 384; LAS float* nv = fl + 448;
    const int tid = otid(), wid = tid >> 6, lane = tid & 63, fr = lane & 15, fq = lane >> 4;
    for (int item = obid(); item < 2048; item += gridDim.x) {
        const int b = item >> 10, h = (item >> 8) & 3, c = item & 255;
        for (int g = 0; g < 2; ++g) {
            const int j = g ? 255 - c : c, chain = g * 8 + b * 4 + h, it = chain * 256 + j;
            if (wid == 0) { const int t = g ? (64 * c + 63 - lane) : (64 * c + lane); const size_t row = (size_t)b * S_ + t;
                const float fpre = GATES[row * 16 + g * 8 + 4 + h], ipre = GATES[row * 16 + g * 8 + h];
                float bc = logsig(fpre);
                for (int o = 1; o < 64; o <<= 1) { const float v = __shfl_up(bc, o); if (lane >= o) bc += v; }
                const float e = ipre - bc; float cm = e;
                for (int o = 1; o < 64; o <<= 1) { const float v = __shfl_up(cm, o); if (lane >= o) cm = fmaxf(cm, v); }
                const float m = MLM[it], Mi = fmaxf(m, cm);
                bcum[lane] = bc; et[lane] = e; Ms[lane] = Mi; wint[lane] = __expf(m - Mi); nv[lane] = MLDN[(size_t)it * 64 + lane]; }
            { const int i = tid >> 3, sg = tid & 7; const int t = g ? (64 * c + 63 - i) : (64 * c + i); const bf16_t* zr = Z + ((size_t)b * S_ + t) * 2560;
                *(LAS bf16x8*)(Qs + i * 72 + sg * 8) = *(const bf16x8*)(zr + h * 64 + sg * 8);
                *(LAS bf16x8*)(Ks + i * 72 + sg * 8) = *(const bf16x8*)(zr + 256 + h * 64 + sg * 8);
#pragma unroll
                for (int hh = 0; hh < 2; ++hh) { const bf16x8 vv = *(const bf16x8*)(zr + 512 + h * 128 + (sg + 8 * hh) * 8);
#pragma unroll
                    for (int e = 0; e < 8; ++e) Vt[((sg + 8 * hh) * 8 + e) * 72 + i] = (bf16_t)vv[e]; }
#pragma unroll
                for (int hh = 0; hh < 2; ++hh) { const int idx = tid + 512 * hh, v = idx >> 3, s8 = idx & 7;
                    *(LAS bf16x8*)(Cs + v * 72 + s8 * 8) = *(const bf16x8*)(MLC + (size_t)it * 8192 + v * 64 + s8 * 8); } }
            __syncthreads();
            { const int i = tid >> 3, p = tid & 7; const float wi = wint[i]; float part = 0.f;
#pragma unroll
                for (int e = 0; e < 8; ++e) { const float q = bf2f(Qs[i * 72 + p * 8 + e]); Qw[i * 72 + p * 8 + e] = f2bf(q * wi); part += nv[p * 8 + e] * q; }
                part += __shfl_xor(part, 1); part += __shfl_xor(part, 2); part += __shfl_xor(part, 4);
                if (p == 0) deni[i] = part * wi; }
            { const int ti = wid >> 1, ts0 = (wid & 1) * 2; f32x4 acc[2] = {(f32x4){0.f, 0.f, 0.f, 0.f}, (f32x4){0.f, 0.f, 0.f, 0.f}};
#pragma unroll
                for (int kk = 0; kk < 2; ++kk) { const bf16x8 av = lfrag(Qs, 72, ti * 16 + fr, kk * 32 + 8 * fq);
#pragma unroll
                    for (int u = 0; u < 2; ++u) acc[u] = mma16(av, lfrag(Ks, 72, (ts0 + u) * 16 + fr, kk * 32 + 8 * fq), acc[u]); }
#pragma unroll
                for (int r = 0; r < 4; ++r) { const int i = ti * 16 + 4 * fq + r; const float Mi = Ms[i]; float rsum = 0.f;
#pragma unroll
                    for (int u = 0; u < 2; ++u) { const int s = (ts0 + u) * 16 + fr; const float val = (s <= i) ? acc[u][r] * __expf(et[s] - Mi) : 0.f; Sm[i * 72 + s] = f2bf(val); rsum += val; }
                    rsum = row16_sum(rsum); if (fr == 0) denp[i * 2 + (wid & 1)] = rsum; } }
            __syncthreads();
            { const int ti = wid >> 1, tv0 = (wid & 1) * 4; f32x4 acc[4];
#pragma unroll
                for (int u = 0; u < 4; ++u) acc[u] = (f32x4){0.f, 0.f, 0.f, 0.f};
#pragma unroll
                for (int kk = 0; kk < 2; ++kk) { const bf16x8 av = lfrag(Sm, 72, ti * 16 + fr, kk * 32 + 8 * fq);
#pragma unroll
                    for (int u = 0; u < 4; ++u) acc[u] = mma16(av, lfrag(Vt, 72, (tv0 + u) * 16 + fr, kk * 32 + 8 * fq), acc[u]); }
#pragma unroll
                for (int kk = 0; kk < 2; ++kk) { const bf16x8 av = lfrag(Qw, 72, ti * 16 + fr, kk * 32 + 8 * fq);
#pragma unroll
                    for (int u = 0; u < 4; ++u) acc[u] = mma16(av, lfrag(Cs, 72, (tv0 + u) * 16 + fr, kk * 32 + 8 * fq), acc[u]); }
#pragma unroll
                for (int r = 0; r < 4; ++r) { const int i = ti * 16 + 4 * fq + r; const float den = denp[2 * i] + denp[2 * i + 1] + deni[i];
                    const float dd = fmaxf(fabsf(den), __expf(-(bcum[i] + Ms[i]))), inv = 1.f / dd; const int tl = g ? 63 - i : i;
#pragma unroll
                    for (int u = 0; u < 4; ++u) { const int v = (tv0 + u) * 16 + fr; const float hv = acc[u][r] * inv; if (g == 0) Hacc[tl * 132 + v] = hv; else Hacc[tl * 132 + v] += hv; } } }
            __syncthreads();
        }
        { const int tok = tid >> 3, p = tid & 7; const size_t row = (size_t)b * S_ + 64 * c + tok; float ss = 0.f;
#pragma unroll
            for (int e = 0; e < 16; ++e) { const float hv = Hacc[tok * 132 + p * 16 + e]; ss += hv * hv; }
            ss += __shfl_xor(ss, 1); ss += __shfl_xor(ss, 2); ss += __shfl_xor(ss, 4);
            const float sc = rsqrtf(ss * (1.f / 128.f) + 1e-6f);
            const bf16_t* orow = Z + row * 2560 + 1024 + h * 128 + p * 16; bf16_t* yrow = Y + row * 1024 + h * 128 + p * 16; const float* gn = gain + h * 128 + p * 16;
#pragma unroll
            for (int hh = 0; hh < 2; ++hh) { const bf16x8 ov = *(const bf16x8*)(orow + hh * 8); float y[8];
#pragma unroll
                for (int e = 0; e < 8; ++e) y[e] = Hacc[tok * 132 + p * 16 + hh * 8 + e] * sc * gn[hh * 8 + e] * sigm(bfs2f(ov[e]));
                u32x4 w; w.x = cvt_pk_bf16(y[0], y[1]); w.y = cvt_pk_bf16(y[2], y[3]); w.z = cvt_pk_bf16(y[4], y[5]); w.w = cvt_pk_bf16(y[6], y[7]);
                *(u32x4*)(yrow + hh * 8) = w; } }
        __syncthreads();
    }
}

__device__ __forceinline__ void lru_pass(LAS unsigned char* L, int mode, const bf16_t* Z, const bf16_t* LWT, const float* conv_w, const float* conv_b, const float* b_a, const float* b_x, const float* lam,
                         float* LSUM, const float* LCAR, bf16_t* Y) {
    LAS float* xc = (LAS float*)L; LAS bf16_t* xcb = (LAS bf16_t*)(xc + 64 * 65); LAS bf16_t* LW = xcb + 64 * 72; LAS float* AA = (LAS float*)(LW + 4 * 64 * 72); LAS float* UU = AA + 2 * 64 * 65;
    const int tid = otid(), wid = tid >> 6, lane = tid & 63, fr = lane & 15, fq = lane >> 4;
    int nprev = -1;
    for (int item = obid(); item < 4096; item += gridDim.x) {
        const int b = item >> 11, seg = (item >> 3) & 255, n = item & 7;
        { LAS bf16_t* XS = (LAS bf16_t*)(L + 129280);
            for (int idx = tid; idx < 536; idx += 512) { const int rr = idx >> 3, sg = idx & 7, tt = seg * 64 - 2 + rr; bf16x8 v = (bf16x8){0, 0, 0, 0, 0, 0, 0, 0};
                if (tt >= 0 && tt < S_) v = *(const bf16x8*)(Z + ((size_t)b * S_ + tt) * 2560 + 1536 + n * 64 + sg * 8);
                *(LAS bf16x8*)(XS + rr * 72 + sg * 8) = v; }
            __syncthreads();
            const int d = tid & 63, ch = n * 64 + d; const float cw0 = conv_w[ch], cw1 = conv_w[512 + ch], cw2 = conv_w[1024 + ch], cw3 = conv_w[1536 + ch], cbv = conv_b[ch];
#pragma unroll
            for (int k8 = 0; k8 < 8; ++k8) { const int i = (tid >> 6) + 8 * k8;
                const float acc = cbv + bf2f(XS[i * 72 + d]) * cw0 + bf2f(XS[(i + 1) * 72 + d]) * cw1 + bf2f(XS[(i + 2) * 72 + d]) * cw2 + bf2f(XS[(i + 3) * 72 + d]) * cw3;
                xc[i * 65 + d] = acc; xcb[i * 72 + d] = f2bf(acc); } }
        if (n != nprev) { nprev = n;
        for (int idx = tid; idx < 2048; idx += 512) { const int mat = idx >> 9, d = (idx >> 3) & 63, sg = idx & 7, kind = mat >> 1, g = mat & 1;
            *(LAS bf16x8*)(LW + mat * 64 * 72 + d * 72 + sg * 8) = *(const bf16x8*)(LWT + (size_t)(kind * 16 + g * 8 + n) * 4096 + d * 64 + sg * 8); } }
        __syncthreads();
        { const int g = wid >> 2, ti = wid & 3; f32x4 aa[4], ax[4];
#pragma unroll
            for (int td = 0; td < 4; ++td) { aa[td] = (f32x4){0.f, 0.f, 0.f, 0.f}; ax[td] = (f32x4){0.f, 0.f, 0.f, 0.f}; }
#pragma unroll
            for (int kk = 0; kk < 2; ++kk) { const bf16x8 av = lfrag(xcb, 72, ti * 16 + fr, kk * 32 + 8 * fq);
#pragma unroll
                for (int td = 0; td < 4; ++td) { aa[td] = mma16(av, lfrag(LW + g * 64 * 72, 72, td * 16 + fr, kk * 32 + 8 * fq), aa[td]);
                    ax[td] = mma16(av, lfrag(LW + (2 + g) * 64 * 72, 72, td * 16 + fr, kk * 32 + 8 * fq), ax[td]); } }
#pragma unroll
            for (int td = 0; td < 4; ++td) { const int d = td * 16 + fr, ch = n * 64 + d; const float lm = lam[g * 512 + ch]; const float sp = lm > 0.f ? log1pf(expf(-lm)) : -lm + log1pf(expf(lm));
                const float ba_ = b_a[g * 512 + ch], bx_ = b_x[g * 512 + ch];
#pragma unroll
                for (int r = 0; r < 4; ++r) { const int i = ti * 16 + 4 * fq + r; const float la = -8.f * sigm(aa[td][r] + ba_) * sp;
                    const float a_ = __expf(la), x2 = 2.f * la; const float om = (x2 > -0.02f) ? -x2 * (1.f + x2 * (0.5f + x2 * (1.f / 6.f))) : 1.f - a_ * a_;
                    AA[g * 4160 + i * 65 + d] = a_; UU[g * 4160 + i * 65 + d] = __builtin_amdgcn_sqrtf(om) * sigm(ax[td][r] + bx_) * xc[i * 65 + d]; } } }
        __syncthreads();
        if (tid < 128) { const int g = tid >> 6, d = tid & 63, ch = n * 64 + d; const size_t ix = ((size_t)(b * 256 + seg) * 2 + g) * 512 + ch;
            if (mode == 0) { float P = 1.f, E = 0.f;
                for (int st = 0; st < 64; ++st) { const int i = g ? 63 - st : st; const float a_ = AA[g * 4160 + i * 65 + d]; E = a_ * E + UU[g * 4160 + i * 65 + d]; P *= a_; }
                LSUM[2 * ix] = P; LSUM[2 * ix + 1] = E; }
            else { float hc = LCAR[ix];
                for (int st = 0; st < 64; ++st) { const int i = g ? 63 - st : st; hc = AA[g * 4160 + i * 65 + d] * hc + UU[g * 4160 + i * 65 + d]; UU[g * 4160 + i * 65 + d] = hc; } } }
        __syncthreads();
        if (mode == 1) {
            { const int i = tid >> 3, sg = tid & 7; const size_t row = (size_t)b * S_ + seg * 64 + i;
                const bf16x8 gv = *(const bf16x8*)(Z + row * 2560 + 2048 + n * 64 + sg * 8); float y[8];
#pragma unroll
                for (int e = 0; e < 8; ++e) { const int d = sg * 8 + e; y[e] = (UU[i * 65 + d] + UU[4160 + i * 65 + d]) * gelu_tanh(bfs2f(gv[e])); }
                u32x4 w; w.x = cvt_pk_bf16(y[0], y[1]); w.y = cvt_pk_bf16(y[2], y[3]); w.z = cvt_pk_bf16(y[4], y[5]); w.w = cvt_pk_bf16(y[6], y[7]);
                *(u32x4*)(Y + row * 1024 + 512 + n * 64 + sg * 8) = w; }
            __syncthreads();
        }
    }
}
__device__ __forceinline__ void lru_carry(const float* __restrict__ LSUM, float* __restrict__ LCAR) {
    for (int id = obid() * 512 + otid(); id < 2048; id += gridDim.x * 512) {
        const int b = id >> 10, g = (id >> 9) & 1, ch = id & 511; float c = 0.f;
        for (int st = 0; st < 256; ++st) { const int seg = g ? 255 - st : st; const size_t ix = ((size_t)(b * 256 + seg) * 2 + g) * 512 + ch;
            LCAR[ix] = c; c = LSUM[2 * ix] * c + LSUM[2 * ix + 1]; }
    }
}

__device__ __forceinline__ void rw_mix(const float* X, const float* SS, const float* gm, bf16_t* AP) {
    const int wid = otid() >> 6, lane = otid() & 63;
#pragma unroll 2
    for (int row = obid() * 8 + wid; row < T_; row += gridDim.x * 8) {
        const int s = row & (S_ - 1); const bool hp = s > 0, hn = s < S_ - 1;
        const int which = lane >> 4; const bool valid = (which == 1) || (which == 0 && hp) || (which == 2 && hn);
        float v = valid ? SS[(size_t)(row - 1 + which) * 16 + (lane & 15)] : 0.f;
        v = row16_sum(v); const float rsv = rsqrtf(v * (1.f / 1024.f) + 1e-6f);
        const float rp = hp ? __shfl(rsv, 0) : 0.f, rc = __shfl(rsv, 16), rn = hn ? __shfl(rsv, 32) : 0.f;
#pragma unroll
        for (int i = 0; i < 4; ++i) { const int col = i * 256 + lane * 4; const f32x4 g4 = *(const f32x4*)(gm + col);
            const f32x4 xc4 = *(const f32x4*)(X + (size_t)row * 1024 + col);
            f32x4 xp4 = {0.f, 0.f, 0.f, 0.f}, xn4 = {0.f, 0.f, 0.f, 0.f};
            if (hp) xp4 = *(const f32x4*)(X + (size_t)(row - 1) * 1024 + col);
            if (hn) xn4 = *(const f32x4*)(X + (size_t)(row + 1) * 1024 + col);
            const f32x4 u = xc4 * rc * g4, up = xp4 * rp * g4, un = xn4 * rn * g4; const f32x4 xx = (up + un) * 0.5f - u;
            u32x2 w; w.x = cvt_pk_bf16(u[0], u[1]); w.y = cvt_pk_bf16(u[2], u[3]); *(u32x2*)(AP + (size_t)row * 2048 + col) = w;
            u32x2 w2; w2.x = cvt_pk_bf16(xx[0], xx[1]); w2.y = cvt_pk_bf16(xx[2], xx[3]); *(u32x2*)(AP + (size_t)row * 2048 + 1024 + col) = w2; }
    }
}

typedef float f32x2 __attribute__((ext_vector_type(2)));
#define RW_BAR() do { asm volatile("s_waitcnt lgkmcnt(0)" ::: "memory"); __builtin_amdgcn_s_barrier(); asm volatile("" ::: "memory"); } while (0)
__device__ __forceinline__ f32x4 unpk4(u32x2 w) { return (f32x4){__uint_as_float(w.x << 16), __uint_as_float(w.x & 0xffff0000u), __uint_as_float(w.y << 16), __uint_as_float(w.y & 0xffff0000u)}; }
__device__ __forceinline__ f32x4 sigm4(f32x4 x) { return (f32x4){sigm(x[0]), sigm(x[1]), sigm(x[2]), sigm(x[3])}; }
__device__ __forceinline__ f32x4 exp4(f32x4 x) { return (f32x4){__expf(x[0]), __expf(x[1]), __expf(x[2]), __expf(x[3])}; }
__device__ __forceinline__ u32x2 pk4(f32x4 x) { u32x2 w; w.x = cvt_pk_bf16(x[0], x[1]); w.y = cvt_pk_bf16(x[2], x[3]); return w; }
template <int CTRL> __device__ __forceinline__ float dpp0(float x) { return __builtin_bit_cast(float, __builtin_amdgcn_update_dpp(0, __builtin_bit_cast(int, x), CTRL, 0xf, 0xf, true)); }
__device__ __forceinline__ float row16_scan(float x) { x += dpp0<0x111>(x); x += dpp0<0x112>(x); x += dpp0<0x114>(x); x += dpp0<0x118>(x); return x; }
__device__ __forceinline__ bf16x8 pack8(f32x4 lo, f32x4 hi) { u32x4 w; w.x = cvt_pk_bf16(lo[0], lo[1]); w.y = cvt_pk_bf16(lo[2], lo[3]); w.z = cvt_pk_bf16(hi[0], hi[1]); w.w = cvt_pk_bf16(hi[2], hi[3]); return __builtin_bit_cast(bf16x8, w); }
__device__ __forceinline__ bf16x8 pack8il(f32x4 u, u32x2 vp) { const unsigned u01 = cvt_pk_bf16(u[0], u[1]), u23 = cvt_pk_bf16(u[2], u[3]); u32x4 w;
    w.x = (u01 & 0xffffu) | (vp.x << 16); w.y = (u01 >> 16) | (vp.x & 0xffff0000u); w.z = (u23 & 0xffffu) | (vp.y << 16); w.w = (u23 >> 16) | (vp.y & 0xffff0000u); return __builtin_bit_cast(bf16x8, w); }
__device__ __forceinline__ bf16x8 pack8v(f32x4 lo, u32x2 hi) { u32x4 w; w.x = cvt_pk_bf16(lo[0], lo[1]); w.y = cvt_pk_bf16(lo[2], lo[3]); w.z = hi.x; w.w = hi.y; return __builtin_bit_cast(bf16x8, w); }
__device__ __forceinline__ void rw_scan(LAS unsigned char* L, const bf16_t* Rg, const bf16_t* Kg, const bf16_t* Vg, const bf16_t* VF, const bf16_t* LO, const bf16_t* wlbT, const bf16_t* albT, const bf16_t* vlbT,
                        const float* w0, const float* a0, const float* v0, const float* k_k, const float* k_a, const float* r_k, bf16_t* WKV, float* BON2) {
    LAS bf16_t* BTw = (LAS bf16_t*)L; LAS bf16_t* BTa = BTw + 64 * 72; LAS bf16_t* BTv = BTa + 64 * 72;
    LAS float* CSTb = (LAS float*)(L + 23552);
    LAS bf16_t* BD = (LAS bf16_t*)(L + 25088); LAS bf16_t* KD = (LAS bf16_t*)(L + 34304);
    LAS float* MM = (LAS float*)(L + 43520);
    LAS bf16_t* OUTb = (LAS bf16_t*)(L + 48640);
    constexpr int SET0 = 53248, SETSZ = 52480;
    const int tid = otid(), wid = tid >> 6, lane = tid & 63, fr = lane & 15, fq = lane >> 4;
    const bool hasvf = VF != nullptr;
    const bf16x8 zero8 = (bf16x8){0, 0, 0, 0, 0, 0, 0, 0};
    for (int wk0 = obid(); wk0 < 256; wk0 += gridDim.x) {
        const int wk = ((wk0 & 7) << 5) | (wk0 >> 3);
        const int chain = wk >> 2, q = wk & 3, g = chain >> 5, b = (chain >> 4) & 1, h = chain & 15;
        { const int tid2 = otid(); const int d = tid2 >> 3, sg = tid2 & 7;
            *(LAS bf16x8*)(BTw + d * 72 + sg * 8) = *(const bf16x8*)(wlbT + ((size_t)g * 1024 + h * 64 + d) * 64 + sg * 8);
            *(LAS bf16x8*)(BTa + d * 72 + sg * 8) = *(const bf16x8*)(albT + ((size_t)g * 1024 + h * 64 + d) * 64 + sg * 8);
            if (hasvf && tid2 < 256) { const int d2 = tid2 >> 2, s2 = tid2 & 3; *(LAS bf16x8*)(BTv + d2 * 40 + s2 * 8) = *(const bf16x8*)(vlbT + (size_t)(h * 64 + d2) * 32 + s2 * 8); }
            if (tid2 < 384) { const int arr = tid2 >> 6, d3 = tid2 & 63, col = h * 64 + d3;
                float v = 0.f; if (arr == 0) v = w0[g * 1024 + col]; else if (arr == 1) v = hasvf ? v0[col] : 0.f; else if (arr == 2) v = a0[g * 1024 + col]; else if (arr == 3) v = k_k[col]; else if (arr == 4) v = k_a[col]; else v = r_k[col];
                CSTb[arr * 64 + d3] = v; }
            for (int idx = tid2; idx < 4096; idx += 512) { const int st = idx >> 11, w = idx & 2047;
                ((LAS unsigned*)(L + SET0 + st * SETSZ + (w < 1024 ? 35840 : 45056 - 4096)))[w] = 0u; } }
        __syncthreads();
        const int ti = wid & 3, half = wid >> 2;
        const int cb = h * 64 + 4 * fq;
        const bool hasv = (half == 1);
        bf16x8 flw0, flw1, fla0, fla1, flv = zero8; u32x2 xK[4], xR[2], xV = (u32x2){0u, 0u}, xVF = (u32x2){0u, 0u}; size_t rowg = 0;
#define RW_LOADS(n_) do { const int st_ = 64 * (n_) + ti * 16 + fr, t_ = g ? (S_ - 1 - st_) : st_; rowg = (size_t)b * S_ + t_; const bf16_t* lo_ = LO + rowg * 512; \
            flw0 = *(const bf16x8*)(lo_ + g * 64 + 8 * fq); flw1 = *(const bf16x8*)(lo_ + g * 64 + 32 + 8 * fq); fla0 = *(const bf16x8*)(lo_ + 128 + g * 64 + 8 * fq); fla1 = *(const bf16x8*)(lo_ + 128 + g * 64 + 32 + 8 * fq); \
            if (hasvf && hasv) flv = *(const bf16x8*)(lo_ + 416 + 8 * fq); \
            _Pragma("unroll") for (int td = 0; td < 4; ++td) xK[td] = *(const u32x2*)(Kg + rowg * 1024 + cb + td * 16); \
            _Pragma("unroll") for (int tl = 0; tl < 2; ++tl) xR[tl] = *(const u32x2*)(Rg + rowg * 1024 + cb + (2 * half + tl) * 16); \
            if (hasv) { xV = *(const u32x2*)(Vg + rowg * 1024 + cb + q * 16); if (hasvf) xVF = *(const u32x2*)(VF + rowg * 1024 + cb + q * 16); } } while (0)
        RW_LOADS(0);
        f32x4 ST[4];
#pragma unroll
        for (int kt = 0; kt < 4; ++kt) ST[kt] = (f32x4){0.f, 0.f, 0.f, 0.f};
#pragma unroll 2
        for (int m = 0; m < 258; ++m) {
            LAS unsigned char* setp = L + SET0 + (m & 1) * SETSZ;
            LAS bf16_t* KQ = (LAS bf16_t*)setp; LAS bf16_t* RQ = (LAS bf16_t*)(setp + 9216); LAS bf16_t* W2 = (LAS bf16_t*)(setp + 18432); LAS bf16_t* NA = (LAS bf16_t*)(setp + 35840);
            LAS bf16_t* AR = (LAS bf16_t*)(setp + 39936); LAS bf16_t* TI = (LAS bf16_t*)(setp + 45056); LAS float* LLs = (LAS float*)(setp + 49152); LAS bf16_t* Vt = (LAS bf16_t*)(setp + 50176);
            if (wid == 0) __builtin_amdgcn_s_setprio(3);
            if (wid == 0) {
                if (m >= 1 && m <= 256) {
                    LAS unsigned char* sp = L + SET0 + ((m - 1) & 1) * SETSZ;
                    const LAS bf16_t* cKQ = (const LAS bf16_t*)sp; const LAS bf16_t* cRQ = (const LAS bf16_t*)(sp + 9216); const LAS bf16_t* cW2 = (const LAS bf16_t*)(sp + 18432); const LAS bf16_t* cNA = (const LAS bf16_t*)(sp + 35840);
                    const LAS bf16_t* cAR = (const LAS bf16_t*)(sp + 39936); const LAS bf16_t* cTI = (const LAS bf16_t*)(sp + 45056); const LAS float* cLL = (const LAS float*)(sp + 49152); const LAS bf16_t* cVt = (const LAS bf16_t*)(sp + 50176);
                    LAS bf16_t* ob = OUTb + ((m - 1) & 1) * (64 * 18);
                    const f32x4 z4 = {0.f, 0.f, 0.f, 0.f};
#pragma unroll 2
                    for (int sc = 0; sc < 4; ++sc) {
                        const bf16x8 s01 = pack8(ST[0], ST[1]), s23 = pack8(ST[2], ST[3]);
                        const u32x2 vp = *(const LAS u32x2*)(cVt + fr * 72 + sc * 16 + 4 * fq);
                        f32x4 X = mma16(lfrag(cKQ, 72, sc * 16 + fr, 8 * fq), s01, z4); X = mma16(lfrag(cKQ, 72, sc * 16 + fr, 32 + 8 * fq), s23, X);
                        X = mma16(lfrag(cNA, 32, sc * 16 + fr, 8 * fq), pack8v(z4, vp), X);
                        const f32x4 U = mma16(lfrag(cTI, 32, sc * 16 + fr, 8 * fq), pack8(X, z4), z4);
                        const bf16x8 uv = pack8il(U, vp);
                        f32x4 O = mma16(lfrag(cRQ, 72, sc * 16 + fr, 8 * fq), s01, z4); O = mma16(lfrag(cRQ, 72, sc * 16 + fr, 32 + 8 * fq), s23, O);
#pragma unroll
                        for (int kt = 0; kt < 4; ++kt) { const f32x4 ll = *(const LAS f32x4*)(cLL + sc * 64 + kt * 16 + 4 * fq);
                            ST[kt] = mma16(lfrag(cW2, 136, kt * 16 + fr, sc * 32 + 8 * fq), uv, ST[kt] * ll); }
                        O = mma16(lfrag(cAR, 40, sc * 16 + fr, 8 * fq), uv, O);
#pragma unroll
                        for (int r = 0; r < 4; ++r) ob[(sc * 16 + 4 * fq + r) * 18 + fr] = f2bf(O[r]);
                    }
                }
            }
            if (m < 256) {
                const size_t rowcur = rowg; const int irow = ti * 16 + fr;
                f32x4 accw[2], acca[2], accv = (f32x4){0.f, 0.f, 0.f, 0.f};
#pragma unroll
                for (int tl = 0; tl < 2; ++tl) { const int td = 2 * half + tl; accw[tl] = (f32x4){0.f, 0.f, 0.f, 0.f}; acca[tl] = (f32x4){0.f, 0.f, 0.f, 0.f};
                    accw[tl] = mma16(lfrag(BTw, 72, td * 16 + fr, 8 * fq), flw0, accw[tl]); accw[tl] = mma16(lfrag(BTw, 72, td * 16 + fr, 32 + 8 * fq), flw1, accw[tl]);
                    acca[tl] = mma16(lfrag(BTa, 72, td * 16 + fr, 8 * fq), fla0, acca[tl]); acca[tl] = mma16(lfrag(BTa, 72, td * 16 + fr, 32 + 8 * fq), fla1, acca[tl]); }
                if (hasvf && hasv) accv = mma16(lfrag(BTv, 40, q * 16 + fr, 8 * fq), flv, accv);
                float n2 = 0.f;
#pragma unroll
                for (int td = 0; td < 4; ++td) { const f32x4 kk_ = unpk4(xK[td]) * *(const LAS f32x4*)(CSTb + 192 + td * 16 + 4 * fq); n2 += (kk_[0] * kk_[0] + kk_[1] * kk_[1]) + (kk_[2] * kk_[2] + kk_[3] * kk_[3]); }
                n2 += __shfl_xor(n2, 16); n2 += __shfl_xor(n2, 32);
                const float inv = fminf(__builtin_amdgcn_rsqf(n2), 1e12f);
                const f32x4 krs0 = unpk4(half ? xK[2] : xK[0]), krs1 = unpk4(half ? xK[3] : xK[1]), r4s0 = unpk4(xR[0]), r4s1 = unpk4(xR[1]); const f32x4 v4u = unpk4(xV), vf4u = unpk4(xVF);
                asm volatile("" ::: "memory");
                if (m + 1 < 256) RW_LOADS(m + 1);
                float bs = 0.f;
#pragma unroll
                for (int tl = 0; tl < 2; ++tl) { const int td = 2 * half + tl; const int c4 = td * 16 + 4 * fq;
                    const f32x4 lw = sigm4(*(const LAS f32x4*)(CSTb + c4) + accw[tl]) * (-0.6065306597126334f * 1.4426950408889634f);
                    f32x4 cl;
#pragma unroll
                    for (int r = 0; r < 4; ++r) cl[r] = row16_scan(lw[r]);
                    const f32x4 ep = (f32x4){__builtin_amdgcn_exp2f(cl[0]), __builtin_amdgcn_exp2f(cl[1]), __builtin_amdgcn_exp2f(cl[2]), __builtin_amdgcn_exp2f(cl[3])};
                    f32x4 epL, em, en;
#pragma unroll
                    for (int r = 0; r < 4; ++r) { epL[r] = __shfl(ep[r], (lane & 48) | 15); const float sh = dpp0<0x111>(ep[r]); em[r] = (fr == 0) ? 1.f : sh; en[r] = __builtin_amdgcn_rcpf(ep[r]); }
                    const f32x4 eL = epL * en;
                    const f32x4 a4 = sigm4(*(const LAS f32x4*)(CSTb + 128 + c4) + acca[tl]);
                    const f32x4 kr = tl ? krs1 : krs0; const f32x4 kk4 = kr * *(const LAS f32x4*)(CSTb + 192 + c4) * inv;
                    const f32x4 kd4 = kr * (1.f + (a4 - 1.f) * *(const LAS f32x4*)(CSTb + 256 + c4)); const f32x4 b4 = kk4 * a4; const f32x4 r4 = tl ? r4s1 : r4s0;
                    if (ti == q) { const f32x4 rk = r4 * kd4 * *(const LAS f32x4*)(CSTb + 320 + c4); bs += (rk[0] + rk[1]) + (rk[2] + rk[3]); }
                    const int p4 = 32 * (td >> 1) + 8 * fq + 4 * (td & 1);
                    *(LAS u32x2*)(KQ + irow * 72 + p4) = pk4(kk4 * em); *(LAS u32x2*)(RQ + irow * 72 + p4) = pk4(r4 * ep);
                    *(LAS u32x2*)(BD + irow * 72 + p4) = pk4(b4 * en); *(LAS u32x2*)(KD + irow * 72 + p4) = pk4(kd4 * en);
                    const f32x4 bl = b4 * eL, kl = kd4 * eL;
#pragma unroll
                    for (int r = 0; r < 4; ++r) *(LAS unsigned*)(W2 + (c4 + r) * 136 + ti * 32 + 8 * (fr >> 2) + 2 * (fr & 3)) = cvt_pk_bf16(bl[r], kl[r]);
                    if (fr == 15) *(LAS f32x4*)(LLs + ti * 64 + c4) = epL;
                }
                if (ti == q) { bs += __shfl_xor(bs, 16); bs += __shfl_xor(bs, 32);
                    if (fq == 0) BON2[((size_t)(g * 2 + half) * T_ + rowcur) * 16 + h] = bs; }
                if (hasv) { f32x4 v4 = v4u;
                    if (hasvf) { const f32x4 vf4 = vf4u; v4 = v4 + (vf4 - v4) * sigm4(*(const LAS f32x4*)(CSTb + 64 + q * 16 + 4 * fq) + accv); }
#pragma unroll
                    for (int r = 0; r < 4; ++r) Vt[(4 * fq + r) * 72 + irow] = f2bf(v4[r]); }
            }
            if (wid == 0) __builtin_amdgcn_s_setprio(0);
            if (m >= 2) {
                const LAS bf16_t* ob = OUTb + (m & 1) * (64 * 18);
                const int i = tid >> 3, rr = (tid & 7) * 2; const int st = 64 * (m - 2) + i, t = g ? (S_ - 1 - st) : st; const size_t row = (size_t)b * S_ + t;
                *(unsigned*)(WKV + ((size_t)g * T_ + row) * 1024 + h * 64 + 16 * q + rr) = *(const LAS unsigned*)(ob + i * 18 + rr);
            }
            RW_BAR();
            if (m < 256) { const int sc = wid & 3, brole = wid >> 2;
#pragma unroll
                for (int ml = 0; ml < 3; ++ml) { const int mat = brole ? ml + 1 : 0; if (brole == 0 && ml > 0) break;     const LAS bf16_t* Am = (mat < 2) ? KQ : RQ; const LAS bf16_t* Bm = (mat & 1) ? KD : BD;
                    f32x4 acc = {0.f, 0.f, 0.f, 0.f};
                    acc = mma16(lfrag(Am, 72, sc * 16 + fr, 8 * fq), lfrag(Bm, 72, sc * 16 + fr, 8 * fq), acc);
                    acc = mma16(lfrag(Am, 72, sc * 16 + fr, 32 + 8 * fq), lfrag(Bm, 72, sc * 16 + fr, 32 + 8 * fq), acc);
#pragma unroll
                    for (int r = 0; r < 4; ++r) { const int t = 4 * fq + r, sidx = fr; const bool keep = (mat < 2) ? (sidx < t) : (sidx <= t); const float val = keep ? acc[r] : 0.f;
                        if (mat == 0) MM[(sc * 16 + t) * 20 + sidx] = val;
                        else if (mat == 1) NA[(sc * 16 + t) * 32 + 8 * (sidx >> 2) + 4 + (sidx & 3)] = f2bf(val);
                        else if (mat == 2) AR[(sc * 16 + t) * 40 + 8 * (sidx >> 2) + 2 * (sidx & 3)] = f2bf(val);
                        else AR[(sc * 16 + t) * 40 + 8 * (sidx >> 2) + 2 * (sidx & 3) + 1] = f2bf(val); } }
                if (brole == 0) { asm volatile("" ::: "memory");
                    const int c = lane & 15; float tcol[16];
#pragma unroll
                    for (int i = 0; i < 16; ++i) { float acc0 = (i == c) ? 1.f : 0.f, acc1 = 0.f;
#pragma unroll
                        for (int j4 = 0; j4 < 4; ++j4) { if (j4 * 4 < i) { const f32x4 m4 = *(const LAS f32x4*)(MM + (sc * 16 + i) * 20 + j4 * 4);
#pragma unroll
                                for (int jr = 0; jr < 4; ++jr) { const int j = j4 * 4 + jr; if (j < i) { if (jr & 1) acc1 -= m4[jr] * tcol[j]; else acc0 -= m4[jr] * tcol[j]; } } } }
                        tcol[i] = acc0 + acc1; }
                    if (lane < 16) {
#pragma unroll
                        for (int i = 0; i < 16; ++i) TI[(sc * 16 + i) * 32 + 8 * (c >> 2) + (c & 3)] = f2bf(-tcol[i]); } }
            }
            RW_BAR();
        }
#undef RW_LOADS
        __syncthreads();
    }
}

__device__ __forceinline__ void rw_post(const bf16_t* Vg, const bf16_t* VF, const bf16_t* LO, const bf16_t* gbT, const bf16_t* vlbT, const float* v0, const bf16_t* WKV, const float* BON, const float* ln_w, const float* ln_b, bf16_t* Y, bf16_t* VFout) {
    const int tid = otid(), wid = tid >> 6, lane = tid & 63, fr = lane & 15, fq = lane >> 4;
    const bool hasvf = VF != nullptr;
    int hprev = -1;
    bf16x8 gbf[4][5], vlf[4];
#pragma unroll
    for (int td = 0; td < 4; ++td) { vlf[td] = (bf16x8){0, 0, 0, 0, 0, 0, 0, 0};
#pragma unroll
        for (int kk = 0; kk < 5; ++kk) gbf[td][kk] = vlf[td]; }
    for (int item = obid(); item < 4096; item += gridDim.x) {
        const int tile = item >> 4, h = item & 15; const int cb = h * 64 + 4 * fq;
        if (h != hprev) { hprev = h;
#pragma unroll
            for (int td = 0; td < 4; ++td) {
#pragma unroll
                for (int kk = 0; kk < 5; ++kk) gbf[td][kk] = *(const bf16x8*)(gbT + (size_t)(h * 64 + td * 16 + fr) * 160 + kk * 32 + 8 * fq);
                if (hasvf) vlf[td] = *(const bf16x8*)(vlbT + (size_t)(h * 64 + td * 16 + fr) * 32 + 8 * fq); } }
        const size_t row = (size_t)tile * 128 + wid * 16 + fr;
        const bf16_t* lo = LO + row * 512;
        bf16x8 lf[5], lvf = (bf16x8){0, 0, 0, 0, 0, 0, 0, 0};
#pragma unroll
        for (int kk = 0; kk < 5; ++kk) lf[kk] = *(const bf16x8*)(lo + 256 + kk * 32 + 8 * fq);
        if (hasvf) lvf = *(const bf16x8*)(lo + 416 + 8 * fq);
        u32x2 w0[4], w1[4], vv[4], vf[4];
#pragma unroll
        for (int td = 0; td < 4; ++td) { w0[td] = *(const u32x2*)(WKV + row * 1024 + cb + td * 16); w1[td] = *(const u32x2*)(WKV + ((size_t)T_ + row) * 1024 + cb + td * 16);
            vv[td] = *(const u32x2*)(Vg + row * 1024 + cb + td * 16); vf[td] = hasvf ? *(const u32x2*)(VF + row * 1024 + cb + td * 16) : (u32x2){0u, 0u}; }
        const float bon = (BON[row * 16 + h] + BON[((size_t)T_ + row) * 16 + h]) + (BON[((size_t)2 * T_ + row) * 16 + h] + BON[((size_t)3 * T_ + row) * 16 + h]);
        f32x4 acc[4], accv[4];
#pragma unroll
        for (int td = 0; td < 4; ++td) { acc[td] = (f32x4){0.f, 0.f, 0.f, 0.f}; accv[td] = (f32x4){0.f, 0.f, 0.f, 0.f};
#pragma unroll
            for (int kk = 0; kk < 5; ++kk) acc[td] = mma16(gbf[td][kk], lf[kk], acc[td]);
            if (hasvf) accv[td] = mma16(vlf[td], lvf, accv[td]); }
        f32x4 wk[4]; float sum = 0.f;
#pragma unroll
        for (int td = 0; td < 4; ++td) { wk[td] = unpk4(w0[td]) + unpk4(w1[td]); sum += (wk[td][0] + wk[td][1]) + (wk[td][2] + wk[td][3]); }
        sum += __shfl_xor(sum, 16); sum += __shfl_xor(sum, 32);
        const float mean = sum * (1.f / 64.f); float vs = 0.f;
#pragma unroll
        for (int td = 0; td < 4; ++td) { const f32x4 dd = wk[td] - mean; vs += (dd[0] * dd[0] + dd[1] * dd[1]) + (dd[2] * dd[2] + dd[3] * dd[3]); }
        vs += __shfl_xor(vs, 16); vs += __shfl_xor(vs, 32);
        const float rstd = rsqrtf(vs * (1.f / 64.f) + 64e-5f);
#pragma unroll
        for (int td = 0; td < 4; ++td) { f32x4 v4 = unpk4(vv[td]);
            if (hasvf) { const f32x4 vf4 = unpk4(vf[td]); v4 = v4 + (vf4 - v4) * sigm4(*(const f32x4*)(v0 + cb + td * 16) + accv[td]); }
            else *(u32x2*)(VFout + row * 1024 + cb + td * 16) = vv[td];
            const f32x4 y = ((wk[td] - mean) * rstd * *(const f32x4*)(ln_w + cb + td * 16) + *(const f32x4*)(ln_b + cb + td * 16) + v4 * bon) * acc[td];
            *(u32x2*)(Y + row * 1024 + cb + td * 16) = pk4(y); }
    }
}

#define XB_TMO      128
#define XB_XCNT(j)  (256  + 64 * (j))
#define XB_XSUB(j)  (1280 + 64 * (j))
#define XB_XGEN(j)  (2304 + 64 * (j))
#define XB_TOP      3328
#define XB_TOPGEN   3392
#define XCD_BAR_WORDS 3456
#define XB_SPIN_CAP (1u << 22)
__device__ __forceinline__ unsigned xb_ld(unsigned* p)              { return __hip_atomic_load(p, __ATOMIC_RELAXED, __HIP_MEMORY_SCOPE_AGENT); }
__device__ __forceinline__ unsigned xb_add(unsigned* p, unsigned v) { return __hip_atomic_fetch_add(p, v, __ATOMIC_RELAXED, __HIP_MEMORY_SCOPE_AGENT); }
__device__ __forceinline__ unsigned xb_xcc_id() { return (unsigned)__builtin_amdgcn_s_getreg((3 << 11) | 20) & 0xFu; }
#define XB_SPIN(cond, bar) do { unsigned _sp = 0; while (cond) { __builtin_amdgcn_s_sleep(1); \
    if ((++_sp & 255u) == 0u) { if (xb_ld(&(bar)[XB_TMO])) break; if (_sp > XB_SPIN_CAP) { atomicAdd(&(bar)[XB_TMO], 1u); break; } } } } while (0)
struct XcdBarrier { unsigned* bar; unsigned x; volatile LAS unsigned* st; };
__device__ __forceinline__ XcdBarrier xcd_barrier_post(unsigned* bar, volatile LAS unsigned* st) {
    XcdBarrier b; b.bar = bar; b.x = xb_xcc_id(); b.st = st;
    if (__builtin_amdgcn_workitem_id_x() == 0) (void)xb_add(&bar[XB_XCNT(b.x)], 1u);
    return b;
}
__device__ __forceinline__ void xcd_barrier_complete(unsigned* bar, unsigned x, unsigned& nloc, unsigned& nx) {
    const unsigned G = gridDim.x * gridDim.y * gridDim.z;
    unsigned sum, cnt, mine, sp = 0u;
    for (;;) {
        sum = 0u; cnt = 0u; mine = 0u;
#pragma unroll
        for (unsigned j = 0; j < 16; ++j) { const unsigned c = xb_ld(&bar[XB_XCNT(j)]); sum += c; cnt += (c > 0u) ? 1u : 0u; mine = (j == x) ? c : mine; }
        if (sum == G) break;
        __builtin_amdgcn_s_sleep(1);
        if ((++sp & 255u) == 0u) { if (xb_ld(&bar[XB_TMO])) break; if (sp > XB_SPIN_CAP) { atomicAdd(&bar[XB_TMO], 1u); break; } }
    }
    nloc = mine > 0u ? mine : 1u; nx = cnt > 0u ? cnt : 1u;
}
__device__ __forceinline__ void xcd_barrier(const XcdBarrier& b) {
    asm volatile("s_waitcnt vmcnt(0)" ::: "memory");
    __syncthreads();
    if (__builtin_amdgcn_workitem_id_x() == 0) {
        unsigned* bar = b.bar;
        __builtin_amdgcn_s_waitcnt(0);
        unsigned nloc = b.st[0], nx = b.st[1];
        if (nloc == 0u) { xcd_barrier_complete(bar, b.x, nloc, nx); b.st[0] = nloc; b.st[1] = nx; }
        const unsigned old = xb_add(&bar[XB_XSUB(b.x)], 1u);
        const unsigned gen = old / nloc;
        if (old + 1u == (gen + 1u) * nloc) {
            __builtin_amdgcn_fence(__ATOMIC_RELEASE, "agent");
            asm volatile("s_waitcnt vmcnt(0)" ::: "memory");
            const unsigned og = xb_add(&bar[XB_TOP], 1u);
            const unsigned tg = og / nx;
            if (og + 1u == (tg + 1u) * nx) xb_add(&bar[XB_TOPGEN], 1u);
            else XB_SPIN(xb_ld(&bar[XB_TOPGEN]) == tg, bar);
            __builtin_amdgcn_fence(__ATOMIC_ACQUIRE, "agent");
            xb_add(&bar[XB_XGEN(b.x)], 1u);
            asm volatile("s_waitcnt vmcnt(0)" ::: "memory");
        } else {
            XB_SPIN(xb_ld(&bar[XB_XGEN(b.x)]) == gen, bar);
            __builtin_amdgcn_fence(__ATOMIC_ACQUIRE, "agent");
            asm volatile("s_waitcnt vmcnt(0)" ::: "memory");
        }
    }
    __syncthreads();
}

__global__ void __launch_bounds__(512) mega(Args a) {
    extern __shared__ __attribute__((aligned(16))) unsigned char lds_raw[];
    LAS unsigned char* L = (LAS unsigned char*)lds_raw;
    cg::grid_group grid = cg::this_grid();
    unsigned char* ws = a.ws;
    float* X = a.out;
    float* SS = (float*)(ws + OFF_SS); float* GATES = (float*)(ws + OFF_GATES); float* LSUM = (float*)(ws + OFF_LSUM); float* LCAR = (float*)(ws + OFF_LCAR); float* BON = (float*)(ws + OFF_LSUM);
    float* MLG = (float*)(ws + OFF_MLAUX); float* MLA = MLG + 4096; float* MLM = MLA + 4096; float* MLDN = (float*)(ws + OFF_MLAUX + MiB);
    bf16_t* bufA = (bf16_t*)(ws + OFF_XB); bf16_t* bufB = (bf16_t*)(ws + OFF_XB + 64 * MiB); bf16_t* VFb = (bf16_t*)(ws + OFF_VF);
    bf16_t* Zb = (bf16_t*)(ws + OFF_BIG); bf16_t* MLC = (bf16_t*)(ws + OFF_BIG + 160 * MiB); bf16_t* HB = (bf16_t*)(ws + OFF_BIG);
    bf16_t* Rb = (bf16_t*)(ws + OFF_BIG); bf16_t* Kb = (bf16_t*)(ws + OFF_BIG + 64 * MiB); bf16_t* Vb3 = (bf16_t*)(ws + OFF_BIG + 128 * MiB); bf16_t* LOb = (bf16_t*)(ws + OFF_BIG + 192 * MiB);
    bf16_t* WguT = (bf16_t*)(ws + OFF_WFFN); bf16_t* WdT = (bf16_t*)(ws + OFF_WFFN + 11 * MiB);
    const int G = gridDim.x;
    volatile LAS unsigned* bst = (volatile LAS unsigned*)(L + LDS_BYTES - 16);
    if (otid() < 4) bst[otid()] = 0u;
    __syncthreads();
    const XcdBarrier xbar = xcd_barrier_post((unsigned*)(ws + OFF_BAR), bst);

    for (int p = a.ph_lo; p < a.ph_hi; ++p) {
        if (p == 0) {
#ifndef NO_P0
            p0_rows(a.in[0], X, bufA, SS);
#endif
#ifndef NO_P0
            cvt_mixer_weights((LAS float*)L, a);
#endif
        } else if (p == 29) {
#ifndef NO_P0
            final_rows(X, SS, a.in[3]);
#endif
        } else {
            const int Lr = (p - 1) / 7, s = (p - 1) % 7, odd = Lr & 1, e = Lr >> 1, o = Lr >> 1;
            unsigned char* wev = ws + OFF_WEV + e * 8 * MiB; unsigned char* wod = ws + OFF_WOD + o * 18 * MiB;
            if (s == 4 || s == 6) {
                pg8::Gemm gm; gm.M = T_; gm.N = 1024;
                if (s == 6) { gm.A = HB; gm.Bt = WdT; gm.K = 2816; }
                else if (!odd) { gm.A = bufB; gm.Bt = (const bf16_t*)(wev + 5 * MiB + MiB / 4); gm.K = 1024; }
                else { gm.A = Rb; gm.Bt = (const bf16_t*)(wod + 14 * MiB); gm.K = 1024; }
                pg8::StaticOrder So; So.init(T_, 1024, G, obid());
                pg8::EpiRes E; E.X = X; E.XB = bufA; E.SS = SS;
#ifndef NO_G1
                pg8::gemm_phase<pg8::EpiRes>(L, gm, So, E);
#endif
            } else if (s == 5) {
                pg8::Gemm gm; gm.A = bufA; gm.Bt = WguT; gm.M = T_; gm.N = 5632; gm.K = 1024;
                pg8::StaticOrder So; So.init(T_, 5632, G, obid());
                pg8::EpiSwi E; E.Hp = HB; E.SS = SS;
#ifndef NO_G2
                pg8::gemm_phase<pg8::EpiSwi>(L, gm, So, E);
#endif
            } else if (!odd) {
                const bf16_t* LWT = (const bf16_t*)(wev + 7 * MiB + MiB / 4);
                if (s == 0) {
                    pg8::Gemm gm; gm.A = bufA; gm.Bt = (const bf16_t*)wev; gm.M = T_; gm.N = 2560; gm.K = 1024;
                    pg8::StaticOrder So; So.init(T_, 2560, G, obid());
                    pg8::EpiZ E; E.Zp = Zb; E.SS = SS;
#ifndef NO_G3
                    pg8::gemm_phase<pg8::EpiZ>(L, gm, So, E);
#endif
#ifndef NO_ML
                    gates_gemm(bufA, (const bf16_t*)(wev + 5 * MiB), SS, a.in[9] + e * 16, GATES);
#endif
                } else if (s == 2) {
#ifndef NO_ML
                    ml_combine(MLC, MLDN, MLG, MLA, MLM);
#endif
#ifndef NO_ML
                    lru_carry(LSUM, LCAR);
#endif
                } else {
#ifndef NO_MLL
                    if (s == 1) ml_local(L, Zb, GATES, MLC, MLDN, MLG, MLA);
                    else ml_out(L, Zb, GATES, MLC, MLDN, MLM, a.in[10] + e * 512, bufB);
#endif
#ifndef NO_LRU
                    lru_pass(L, s == 3 ? 1 : 0, Zb, LWT, a.in[11] + e * 2048, a.in[12] + e * 512, a.in[14] + e * 1024, a.in[16] + e * 1024, a.in[17] + e * 1024, LSUM, LCAR, bufB);
#endif
                }
            } else {
                const bf16_t* VF = o == 0 ? (const bf16_t*)nullptr : (const bf16_t*)VFb;
                const bf16_t* wlbT = (const bf16_t*)(wod + 16 * MiB); const bf16_t* albT = (const bf16_t*)(wod + 16 * MiB + MiB / 4);
                const bf16_t* gbT = (const bf16_t*)(wod + 16 * MiB + MiB / 2); const bf16_t* vlbT = (const bf16_t*)(wod + 16 * MiB + 7 * MiB / 8);
                if (s == 0) {
#ifndef NO_RW
                    rw_mix(X, SS, a.in[1] + Lr * 1024, bufA);
#endif
                } else if (s == 1) {
                    pg8::Gemm gm; gm.A = bufA; gm.Bt = (const bf16_t*)wod; gm.M = T_; gm.N = 3584; gm.K = 2048;
                    pg8::StaticOrder So; So.init(T_, 3584, G, obid());
                    pg8::EpiRKV E; E.Rp = Rb;
#ifndef NO_G4
                    pg8::gemm_phase<pg8::EpiRKV>(L, gm, So, E);
#endif
                } else if (s == 2) {
#ifndef NO_SCAN
                    rw_scan(L, Rb, Kb, Vb3, VF, LOb, wlbT, albT, vlbT, a.in[23] + o * 2048, a.in[26] + o * 2048, a.in[29], a.in[34] + o * 1024, a.in[35] + o * 1024, a.in[36] + o * 1024, bufA, BON);
#endif
                } else {
#ifndef NO_RW
                    rw_post(Vb3, VF, LOb, gbT, vlbT, a.in[29], bufA, BON, a.in[37] + o * 1024, a.in[38] + o * 1024, Rb, VFb);
#endif
                }
            }
#ifndef NO_P0
            if (s == 1) cvt_ffn_weights((LAS float*)L, a, Lr);
#endif
        }
        if (p + 1 < a.ph_hi) { if (p == 0) grid.sync(); else xcd_barrier(xbar); }
    }
}

extern "C" void kernel_launch(void* const* d_in, const int* in_sizes, int n_in, void* d_out, int out_size, void* d_ws, size_t ws_size, hipStream_t stream) {
    static int grid = 0;
    if (grid == 0) {
        if (n_in != 39 || ws_size < WS_NEED) { fprintf(stderr, "kernel_launch: unexpected n_in %d / ws_size %zu\n", n_in, ws_size); grid = -1; return; }
        int dev = 0, cus = 0, per_cu = 0;
        hipGetDevice(&dev); hipDeviceGetAttribute(&cus, hipDeviceAttributeMultiprocessorCount, dev);
        if (hipFuncSetAttribute((const void*)mega, hipFuncAttributeMaxDynamicSharedMemorySize, LDS_BYTES) != hipSuccess) { fprintf(stderr, "kernel_launch: hipFuncSetAttribute failed\n"); grid = -1; return; }
        if (hipOccupancyMaxActiveBlocksPerMultiprocessor(&per_cu, (const void*)mega, 512, LDS_BYTES) != hipSuccess || per_cu < 1) per_cu = 1;
        (void)hipGetLastError();
        grid = cus * per_cu; if (grid > 256) grid = 256;
    }
    if (grid < 0) return;
    Args a{};
    for (int i = 0; i < 39; ++i) a.in[i] = (const float*)d_in[i];
    a.out = (float*)d_out; a.ws = (unsigned char*)d_ws;
    (void)hipMemsetAsync((char*)d_ws + OFF_BAR, 0, 16384, stream);
#if SINGLE_LAUNCH
    a.ph_lo = 0; a.ph_hi = 30;
    void* args[] = {&a};
    hipError_t e = hipLaunchCooperativeKernel((const void*)mega, dim3(grid), dim3(512), args, LDS_BYTES, stream);
    if (e != hipSuccess) fprintf(stderr, "cooperative launch failed: %s (grid %d)\n", hipGetErrorString(e), grid);
#else
    for (int p = 0; p < 30; ++p) { a.ph_lo = p; a.ph_hi = p + 1; hipLaunchKernelGGL(mega, dim3(grid), dim3(512), LDS_BYTES, stream, a); }
#endif
}
```

```cpp
#include <hip/hip_runtime.h>
#include <hip/hip_cooperative_groups.h>
#include <cstdio>
namespace cg = cooperative_groups;

#ifndef SINGLE_LAUNCH
#define SINGLE_LAUNCH 1
#endif

#define LAS __attribute__((address_space(3)))
typedef unsigned short bf16_t;
typedef short bf16x8 __attribute__((ext_vector_type(8)));
typedef float f32x4 __attribute__((ext_vector_type(4)));
typedef unsigned u32x4 __attribute__((ext_vector_type(4)));
typedef unsigned u32x2 __attribute__((ext_vector_type(2)));

constexpr int T_ = 32768, S_ = 16384, D_ = 1024, F_ = 2816;
constexpr int LDS_BYTES = 163840;
constexpr size_t MiB = 1ull << 20;
constexpr size_t OFF_WEV = 0;
constexpr size_t OFF_WOD = 16 * MiB;
constexpr size_t OFF_WFFN = 52 * MiB;
constexpr size_t OFF_SS = 69 * MiB;
constexpr size_t OFF_GATES = 71 * MiB;
constexpr size_t OFF_LSUM = 73 * MiB;
constexpr size_t OFF_LCAR = 77 * MiB;
constexpr size_t OFF_BON = 79 * MiB;
constexpr size_t OFF_MLAUX = 83 * MiB;
constexpr size_t OFF_BAR = 86 * MiB;
constexpr size_t OFF_XB = 88 * MiB;
constexpr size_t OFF_VF = 216 * MiB;
constexpr size_t OFF_BIG = 280 * MiB;
constexpr size_t WS_NEED = 504 * MiB;

struct Args { const float* in[39]; float* out; unsigned char* ws; int ph_lo, ph_hi; };

__device__ __forceinline__ int otid() { int t = __builtin_amdgcn_workitem_id_x(); asm volatile("" : "+v"(t)); return t; }
__device__ __forceinline__ int obid() { int b = __builtin_amdgcn_workgroup_id_x(); asm volatile("" : "+s"(b)); return b; }
typedef __bf16 bf16x2_t __attribute__((ext_vector_type(2)));
typedef float f32x2_t __attribute__((ext_vector_type(2)));
__device__ __forceinline__ unsigned cvt_pk_bf16(float lo, float hi) { const f32x2_t v = {lo, hi}; const bf16x2_t b = __builtin_convertvector(v, bf16x2_t); return __builtin_bit_cast(unsigned, b); }
__device__ __forceinline__ bf16_t f2bf(float f) { return (bf16_t)(cvt_pk_bf16(f, 0.f) & 0xffffu); }
__device__ __forceinline__ float bf2f(bf16_t b) { return __uint_as_float(((unsigned)b) << 16); }
__device__ __forceinline__ float bfs2f(short b) { return __uint_as_float(((unsigned)(unsigned short)b) << 16); }
__device__ __forceinline__ float sigm(float x) { return __builtin_amdgcn_rcpf(1.f + __expf(-x)); }
__device__ __forceinline__ float logsig(float x) { return fminf(x, 0.f) - __logf(1.f + __expf(-fabsf(x))); }
__device__ __forceinline__ float tanh_fast(float x) { float e = __expf(2.f * x); return 1.f - 2.f / (e + 1.f); }
__device__ __forceinline__ float gelu_tanh(float x) { return 0.5f * x * (1.f + tanh_fast(0.7978845608f * (x + 0.044715f * x * x * x))); }
template <int CTRL> __device__ __forceinline__ float dppf(float x) { return __builtin_bit_cast(float, __builtin_amdgcn_mov_dpp(__builtin_bit_cast(int, x), CTRL, 0xf, 0xf, true)); }
__device__ __forceinline__ float row16_sum(float x) { x += dppf<0xB1>(x); x += dppf<0x4E>(x); x += dppf<0x141>(x); x += dppf<0x140>(x); return x; }
__device__ __forceinline__ float wave_sum(float x) { for (int o = 32; o >= 1; o >>= 1) x += __shfl_xor(x, o); return x; }
__device__ __forceinline__ float wave_max(float x) { for (int o = 32; o >= 1; o >>= 1) x = fmaxf(x, __shfl_xor(x, o)); return x; }
__device__ __forceinline__ f32x4 mma16(bf16x8 a, bf16x8 b, f32x4 c) { return __builtin_amdgcn_mfma_f32_16x16x32_bf16(a, b, c, 0, 0, 0); }
__device__ __forceinline__ bf16x8 lfrag(const LAS bf16_t* base, int pitch, int row, int k) { return *(const LAS bf16x8*)(base + row * pitch + k); }
__device__ __forceinline__ float rs_from_ss(const float* SS, size_t row) {
    const f32x4* sp = (const f32x4*)(SS + row * 16); const f32x4 s = sp[0] + sp[1] + sp[2] + sp[3];
    return rsqrtf(((s.x + s.y) + (s.z + s.w)) * (1.0f / 1024.0f) + 1e-6f);
}

__device__ __forceinline__ void rs_batch8(const float* SS, size_t row0, int fq, float (&rs)[2][4]) {
    f32x4 p[2][4];
#pragma unroll
    for (int ai = 0; ai < 2; ++ai)
#pragma unroll
        for (int m = 0; m < 4; ++m) p[ai][m] = *(const f32x4*)(SS + (row0 + ai * 128 + m * 16) * 16 + 4 * fq);
#pragma unroll
    for (int ai = 0; ai < 2; ++ai)
#pragma unroll
        for (int m = 0; m < 4; ++m) { float t = (p[ai][m][0] + p[ai][m][1]) + (p[ai][m][2] + p[ai][m][3]); t += __shfl_xor(t, 16); t += __shfl_xor(t, 32); rs[ai][m] = rsqrtf(t * (1.0f / 1024.0f) + 1e-6f); }
}
namespace pg8 {
constexpr int BM = 256, BK = 64, HALF = 128, HTB = HALF * BK * 2, STAGE_BYTES = 8 * HTB, NXCD = 8, WGM = 8;
__device__ __forceinline__ int lds_byte(int r, int c) { const int st = (r >> 4) * 2 + (c >> 5), rr = r & 15, cc = c & 31, ob = rr * 64 + cc * 2; return st * 1024 + (ob ^ (((ob >> 9) & 1) << 5)); }
__device__ __forceinline__ void stage_rc(int b, int& R, int& C) { const int st = b / 1024, sb = b % 1024, swz = sb ^ (((sb >> 9) & 1) << 5); R = (st >> 1) * 16 + swz / 64; C = (st & 1) * 32 + (swz % 64) / 2; }
__device__ __forceinline__ int perm32(int rho) { const int n = rho >> 4, i = rho & 15; return 8 * (i >> 2) + 4 * n + (i & 3); }
struct Unit { int pm, pn; };
struct Gemm { const bf16_t* A; const bf16_t* Bt; int M, N, K; };
struct StaticOrder {
    int nM, nN, nwg, G, c;
    __device__ __forceinline__ void init(int M, int N, int G_, int c_) { nM = M / BM; nN = N / BM; nwg = nM * nN; G = G_; c = c_; }
    __device__ bool next(int i, Unit& u) const {
        const long L = (long)i * G + c; if (L >= nwg) return false;
        int wgid = (int)L; { const int q = nwg / NXCD, r = nwg % NXCD, xcd = wgid % NXCD, off = wgid / NXCD; wgid = (xcd < r ? xcd * (q + 1) : r * (q + 1) + (xcd - r) * q) + off; }
        const int nig = WGM * nN, gid = wgid / nig, fm = gid * WGM, gsz = (nM - fm) < WGM ? (nM - fm) : WGM;
        u.pm = fm + ((wgid % nig) % gsz); u.pn = (wgid % nig) / gsz; return true;
    }
};

struct EpiZ {
    static constexpr bool PERM = true;
    bf16_t* Zp; const float* SS;
    __device__ __forceinline__ void operator()(const f32x4 (&acc)[2][2][4][2], const Unit& u, int wr, int wc, int fr, int fq) const {
        const int row0 = u.pm * BM + wr * 64 + fr, col0 = u.pn * BM + wc * 32 + 8 * fq;
        float rs8[2][4]; rs_batch8(SS, (size_t)row0, fq, rs8);
#pragma unroll
        for (int ai = 0; ai < 2; ++ai)
#pragma unroll
            for (int m = 0; m < 4; ++m) { const size_t row = row0 + ai * HALF + m * 16; const float rs = rs8[ai][m]; bf16_t* rowp = Zp + row * 2560 + col0;
#pragma unroll
                for (int bj = 0; bj < 2; ++bj) { const f32x4 v0 = acc[ai][bj][m][0] * rs, v1 = acc[ai][bj][m][1] * rs;
                    u32x4 w; w.x = cvt_pk_bf16(v0[0], v0[1]); w.y = cvt_pk_bf16(v0[2], v0[3]); w.z = cvt_pk_bf16(v1[0], v1[1]); w.w = cvt_pk_bf16(v1[2], v1[3]);
                    *(u32x4*)(rowp + bj * HALF) = w; }
                asm volatile("" ::: "memory"); }
    }
};
struct EpiSwi {
    static constexpr bool PERM = true;
    bf16_t* Hp; const float* SS;
    __device__ __forceinline__ void operator()(const f32x4 (&acc)[2][2][4][2], const Unit& u, int wr, int wc, int fr, int fq) const {
        const int row0 = u.pm * BM + wr * 64 + fr, col0 = u.pn * HALF + wc * 32 + 8 * fq;
        float rs8[2][4]; rs_batch8(SS, (size_t)row0, fq, rs8);
#pragma unroll
        for (int ai = 0; ai < 2; ++ai)
#pragma unroll
            for (int m = 0; m < 4; ++m) { const size_t row = row0 + ai * HALF + m * 16; const float rs = rs8[ai][m];
                float hv[8];
#pragma unroll
                for (int n = 0; n < 2; ++n)
#pragma unroll
                    for (int j = 0; j < 4; ++j) { const float g = acc[ai][0][m][n][j] * rs, up = acc[ai][1][m][n][j] * rs; hv[n * 4 + j] = g * sigm(g) * up; }
                u32x4 w; w.x = cvt_pk_bf16(hv[0], hv[1]); w.y = cvt_pk_bf16(hv[2], hv[3]); w.z = cvt_pk_bf16(hv[4], hv[5]); w.w = cvt_pk_bf16(hv[6], hv[7]);
                *(u32x4*)(Hp + row * 2816 + col0) = w;
                asm volatile("" ::: "memory"); }
    }
};
struct EpiRKV {
    static constexpr bool PERM = true;
    bf16_t* Rp;
    __device__ __forceinline__ void operator()(const f32x4 (&acc)[2][2][4][2], const Unit& u, int wr, int wc, int fr, int fq) const {
        const int pn = u.pn; const int row0 = u.pm * BM + wr * 64 + fr;
        const bool lora = pn >= 12; const int sel = lora ? 3 : (pn >> 2); const int ld = lora ? 512 : 1024; const int colt = lora ? (pn - 12) * 256 : (pn & 3) * 256;
        bf16_t* base = Rp + (size_t)sel * 33554432;
        const int col0 = colt + wc * 32 + 8 * fq;
#pragma unroll
        for (int ai = 0; ai < 2; ++ai)
#pragma unroll
            for (int m = 0; m < 4; ++m) { const size_t row = row0 + ai * HALF + m * 16; bf16_t* rowp = base + row * ld + col0;
#pragma unroll
                for (int bj = 0; bj < 2; ++bj) { f32x4 v0 = acc[ai][bj][m][0], v1 = acc[ai][bj][m][1];
                    if (lora) { const int c = col0 + bj * HALF; const int mode = c < 128 ? 1 : (c < 256 ? 0 : (c < 416 ? 2 : 0));
                        if (mode == 1) {
#pragma unroll
                            for (int j = 0; j < 4; ++j) { v0[j] = tanh_fast(v0[j]); v1[j] = tanh_fast(v1[j]); } }
                        else if (mode == 2) {
#pragma unroll
                            for (int j = 0; j < 4; ++j) { v0[j] = sigm(v0[j]); v1[j] = sigm(v1[j]); } } }
                    u32x4 w; w.x = cvt_pk_bf16(v0[0], v0[1]); w.y = cvt_pk_bf16(v0[2], v0[3]); w.z = cvt_pk_bf16(v1[0], v1[1]); w.w = cvt_pk_bf16(v1[2], v1[3]);
                    *(u32x4*)(rowp + bj * HALF) = w; }
                asm volatile("" ::: "memory"); }
    }
};
struct EpiRes {
    static constexpr bool PERM = false;
    float* X; bf16_t* XB; float* SS;
    __device__ __forceinline__ void operator()(const f32x4 (&acc)[2][2][4][2], const Unit& u, int wr, int wc, int fr, int fq) const {
        const int row0 = u.pm * BM + wr * 64 + fr, col0 = u.pn * BM + wc * 32 + 4 * fq;
#pragma unroll
        for (int ai = 0; ai < 2; ++ai)
#pragma unroll
            for (int m = 0; m < 4; ++m) { const size_t row = row0 + ai * HALF + m * 16; float* xr = X + row * 1024 + col0; bf16_t* br = XB + row * 1024 + col0; float ss = 0.f;
#pragma unroll
                for (int bj = 0; bj < 2; ++bj)
#pragma unroll
                    for (int n = 0; n < 2; ++n) { f32x4 x = *(const f32x4*)(xr + bj * HALF + n * 16); x += acc[ai][bj][m][n]; *(f32x4*)(xr + bj * HALF + n * 16) = x;
                        u32x2 w; w.x = cvt_pk_bf16(x[0], x[1]); w.y = cvt_pk_bf16(x[2], x[3]); *(u32x2*)(br + bj * HALF + n * 16) = w;
                        ss += (x[0] * x[0] + x[1] * x[1]) + (x[2] * x[2] + x[3] * x[3]); }
                ss += __shfl_xor(ss, 16); ss += __shfl_xor(ss, 32);
                if (fq == 0) SS[row * 16 + u.pn * 4 + wc] = ss;
                if (m & 1) asm volatile("" ::: "memory"); }
    }
};

template <class Epi>
__device__ __forceinline__ void gemm_phase(LAS unsigned char* lds, const Gemm g, const StaticOrder& S, const Epi& E) {
    const int tid = otid(), wid = __builtin_amdgcn_readfirstlane(tid >> 6), lane = tid & 63, wr = wid >> 2, wc = wid & 3, fr = lane & 15, fq = lane >> 4;
    const int K = g.K, nt = K / BK;
    unsigned voffA[2], voffB[2];
#pragma unroll
    for (int i = 0; i < 2; ++i) { int R, C; stage_rc(tid * 16 + i * 8192, R, C); const int Rb = Epi::PERM ? ((R & ~31) + perm32(R & 31)) : R;
        voffA[i] = (unsigned)(R * K + C) * 2u; voffB[i] = (unsigned)(Rb * K + C) * 2u; }
    const size_t kstep = (size_t)(BK * 2);
    const size_t hstep = (size_t)HALF * K * 2;
    const size_t tstep = 2 * hstep;
    const unsigned ldsw = (unsigned)wid * 1024u;
    const int aoff = lds_byte(wr * 64 + fr, fq * 8), boff = lds_byte(wc * 32 + fr, fq * 8);
#define PG8_SA(b, h) (((b) * 2 + (h)) * HTB)
#define PG8_SB(b, h) ((4 + (b) * 2 + (h)) * HTB)
#define PG8_STAGE(bufoff, gbase, voff) do { _Pragma("unroll") for (int _i = 0; _i < 2; ++_i) \
        __builtin_amdgcn_global_load_lds((const unsigned*)((const char*)(gbase) + (voff)[_i]), (LAS unsigned*)(lds + (bufoff) + ldsw + _i * 8192), 16, 0, 0); } while (0)
#define PG8_LDA(dst, b, h) do { _Pragma("unroll") for (int m = 0; m < 4; ++m) _Pragma("unroll") for (int k = 0; k < 2; ++k) dst[m][k] = *(const LAS bf16x8*)(lds + PG8_SA(b, h) + aoff + m * 2048 + k * 1024); } while (0)
#define PG8_LDB(dst, b, h) do { _Pragma("unroll") for (int n = 0; n < 2; ++n) _Pragma("unroll") for (int k = 0; k < 2; ++k) dst[n][k] = *(const LAS bf16x8*)(lds + PG8_SB(b, h) + boff + n * 2048 + k * 1024); } while (0)
#define PG8_MMA(ai, bj, At, Bt) do { __builtin_amdgcn_s_setprio(1); _Pragma("unroll") for (int m = 0; m < 4; ++m) _Pragma("unroll") for (int n = 0; n < 2; ++n) _Pragma("unroll") for (int k = 0; k < 2; ++k) \
        acc[ai][bj][m][n] = __builtin_amdgcn_mfma_f32_16x16x32_bf16(Bt[n][k], At[m][k], acc[ai][bj][m][n], 0, 0, 0); __builtin_amdgcn_s_setprio(0); } while (0)
#define PG8_WAIT_V(n) asm volatile("s_waitcnt vmcnt(" #n ")" ::: "memory")
#define PG8_WAIT_L(n) asm volatile("s_waitcnt lgkmcnt(" #n ")" ::: "memory")
#define PG8_BAR __builtin_amdgcn_s_barrier()
#define PG8_SCHED __builtin_amdgcn_sched_barrier(0)
    Unit cur, nxt; int ui = 0;
    if (!S.next(0, cur)) return;
    f32x4 acc[2][2][4][2];
#pragma unroll
    for (int a = 0; a < 2; ++a)
#pragma unroll
        for (int b = 0; b < 2; ++b)
#pragma unroll
            for (int m = 0; m < 4; ++m)
#pragma unroll
                for (int n = 0; n < 2; ++n) acc[a][b][m][n] = (f32x4){0.f, 0.f, 0.f, 0.f};
    bf16x8 At[4][2], B0[2][2], B1[2][2];
    const char* cA = (const char*)g.A + (size_t)cur.pm * tstep; const char* cB = (const char*)g.Bt + (size_t)cur.pn * tstep;
    PG8_STAGE(PG8_SB(0, 0), cB, voffB); PG8_STAGE(PG8_SA(0, 0), cA, voffA); PG8_STAGE(PG8_SB(0, 1), cB + hstep, voffB); PG8_STAGE(PG8_SA(0, 1), cA + hstep, voffA);
    if (wr == 1) PG8_BAR;
    PG8_WAIT_V(4); PG8_BAR;
    PG8_STAGE(PG8_SB(1, 0), cB + kstep, voffB); PG8_STAGE(PG8_SA(1, 0), cA + kstep, voffA); PG8_STAGE(PG8_SB(1, 1), cB + hstep + kstep, voffB);
    PG8_WAIT_V(6); PG8_BAR;
    for (;;) {
        const bool has_next = S.next(ui + 1, nxt);
        const char* nA = has_next ? (const char*)g.A + (size_t)nxt.pm * tstep : cA; const char* nB = has_next ? (const char*)g.Bt + (size_t)nxt.pn * tstep : cB;
        for (int t = 0; t < nt; t += 2) {
            const bool last = (t == nt - 2);
            const char* a1 = cA + (size_t)(t + 1) * kstep;
            const char* a2 = last ? nA : cA + (size_t)(t + 2) * kstep; const char* b2 = last ? nB : cB + (size_t)(t + 2) * kstep;
            const char* a3 = a2 + kstep; const char* b3 = b2 + kstep;
            PG8_LDB(B0, 0, 0); PG8_SCHED; PG8_LDA(At, 0, 0); PG8_STAGE(PG8_SA(1, 1), a1 + hstep, voffA);
            PG8_WAIT_L(8); PG8_BAR; PG8_WAIT_L(0); PG8_MMA(0, 0, At, B0); PG8_BAR; PG8_SCHED;
            PG8_LDB(B1, 0, 1); PG8_STAGE(PG8_SB(0, 0), b2, voffB);
            PG8_BAR; PG8_WAIT_L(0); PG8_MMA(0, 1, At, B1); PG8_BAR;
            PG8_LDA(At, 0, 1); PG8_STAGE(PG8_SA(0, 0), a2, voffA);
            PG8_BAR; PG8_WAIT_L(0); PG8_MMA(1, 0, At, B0); PG8_BAR; PG8_SCHED;
            PG8_STAGE(PG8_SB(0, 1), b2 + hstep, voffB);
            PG8_WAIT_V(6); PG8_BAR; PG8_MMA(1, 1, At, B1); PG8_BAR;
            PG8_LDB(B0, 1, 0); PG8_SCHED; PG8_LDA(At, 1, 0); PG8_STAGE(PG8_SA(0, 1), a2 + hstep, voffA);
            PG8_WAIT_L(8); PG8_BAR; PG8_WAIT_L(0); PG8_MMA(0, 0, At, B0); PG8_BAR; PG8_SCHED;
            PG8_LDB(B1, 1, 1); PG8_STAGE(PG8_SB(1, 0), b3, voffB);
            PG8_BAR; PG8_WAIT_L(0); PG8_MMA(0, 1, At, B1); PG8_BAR;
            PG8_LDA(At, 1, 1); PG8_STAGE(PG8_SA(1, 0), a3, voffA);
            PG8_BAR; PG8_WAIT_L(0); PG8_MMA(1, 0, At, B0); PG8_BAR; PG8_SCHED;
            PG8_STAGE(PG8_SB(1, 1), b3 + hstep, voffB);
            PG8_WAIT_V(6); PG8_BAR; PG8_MMA(1, 1, At, B1); PG8_BAR;
        }
        E(acc, cur, wr, wc, fr, fq);
        if (!has_next) break;
#pragma unroll
        for (int a = 0; a < 2; ++a)
#pragma unroll
            for (int b = 0; b < 2; ++b)
#pragma unroll
                for (int m = 0; m < 4; ++m)
#pragma unroll
                    for (int n = 0; n < 2; ++n) acc[a][b][m][n] = (f32x4){0.f, 0.f, 0.f, 0.f};
        cur = nxt; cA = nA; cB = nB; ++ui;
    }
    PG8_WAIT_V(0);
    if (wr == 0) PG8_BAR;
    PG8_BAR;
#undef PG8_SA
#undef PG8_SB
#undef PG8_STAGE
#undef PG8_LDA
#undef PG8_LDB
#undef PG8_MMA
#undef PG8_WAIT_V
#undef PG8_WAIT_L
#undef PG8_BAR
#undef PG8_SCHED
}
}

struct Job { const float* in; int ld_in, K, ncols; bf16_t* out; int ld_out; const float* scale; float mul; int nb; size_t ibs, obs; };
__device__ __forceinline__ void run_job(LAS float* tl, const Job j, int& tile_base) {
    const int tc_n = (j.ncols + 63) >> 6, tk_n = (j.K + 63) >> 6, per = tc_n * tk_n, total = j.nb * per, G = gridDim.x;
    const int start = (obid() - tile_base % G + G) % G;
    const int tid = otid();
    for (int t0 = start; t0 < total; t0 += 4 * G) {
        f32x4 v[4][2];
#pragma unroll
        for (int u = 0; u < 4; ++u) { const int t = t0 + u * G;
#pragma unroll
            for (int hh = 0; hh < 2; ++hh) { v[u][hh] = (f32x4){0.f, 0.f, 0.f, 0.f};
                if (t < total) { const int bi = t / per, r = t % per, tc = r / tk_n, tk = r % tk_n; const int idx = tid + 512 * hh, kk = idx >> 4, cc = (idx & 15) * 4, k = tk * 64 + kk, c = tc * 64 + cc;
                    if (j.in != nullptr && k < j.K && c < j.ncols) { v[u][hh] = *(const f32x4*)(j.in + bi * j.ibs + (size_t)k * j.ld_in + c) * j.mul; if (j.scale) v[u][hh] *= j.scale[k]; } } } }
#pragma unroll
        for (int u = 0; u < 4; ++u)
#pragma unroll
            for (int hh = 0; hh < 2; ++hh) { const int idx = tid + 512 * hh, kk = idx >> 4, cc = (idx & 15) * 4; LAS float* tp = tl + u * 4160 + kk * 65 + cc;
                tp[0] = v[u][hh][0]; tp[1] = v[u][hh][1]; tp[2] = v[u][hh][2]; tp[3] = v[u][hh][3]; }
        __syncthreads();
#pragma unroll
        for (int u = 0; u < 4; ++u) { const int t = t0 + u * G;
            if (t < total) { const int bi = t / per, r = t % per, tc = r / tk_n, tk = r % tk_n; bf16_t* out = j.out + bi * j.obs;
                for (int idx = tid; idx < 2048; idx += 512) { const int cc = idx >> 5, kp = idx & 31, k = tk * 64 + 2 * kp, c = tc * 64 + cc;
                    if (c < j.ncols && k < j.K) *(unsigned*)(out + (size_t)c * j.ld_out + k) = cvt_pk_bf16(tl[u * 4160 + (2 * kp) * 65 + cc], tl[u * 4160 + (2 * kp + 1) * 65 + cc]); } } }
        __syncthreads();
    }
    tile_base += total;
}
#define SETJ(in_, ld_in_, K_, ncols_, out_, ld_out_, scale_, mul_, nb_, ibs_, obs_) do { jb.in = (in_); jb.ld_in = (ld_in_); jb.K = (K_); jb.ncols = (ncols_); jb.out = (out_); jb.ld_out = (ld_out_); \
        jb.scale = (scale_); jb.mul = (mul_); jb.nb = (nb_); jb.ibs = (ibs_); jb.obs = (obs_); } while (0)
__device__ __forceinline__ void cvt_mixer_weights(LAS float* tl, const Args& a) {
    int tb = 0; unsigned char* ws = a.ws; const float* nfp = nullptr; const size_t MM = (size_t)1024 * 1024;
    for (int jid = 0; jid < 16 + 44; ++jid) {
        Job jb; bool ok = true;
        if (jid < 16) {
            const int e = jid >> 3, k = jid & 7;
            bf16_t* WinT = (bf16_t*)(ws + OFF_WEV + e * 8 * MiB); bf16_t* WgT = WinT + 5 * MiB / 2; bf16_t* WoutT = (bf16_t*)(ws + OFF_WEV + e * 8 * MiB + 5 * MiB + MiB / 4); bf16_t* LWT = (bf16_t*)(ws + OFF_WEV + e * 8 * MiB + 7 * MiB + MiB / 4);
            const float* win = a.in[7] + (size_t)e * 1024 * 2576; const float* nm = a.in[1] + (size_t)(2 * e) * 1024;
            if (k == 0) SETJ(win, 2576, 1024, 256, WinT, 1024, nm, 1.f, 1, 0, 0);
            else if (k == 1) SETJ(win + 256, 2576, 1024, 256, WinT + 256 * 1024, 1024, nm, 0.125f, 1, 0, 0);
            else if (k == 2) SETJ(win + 512, 2576, 1024, 1024, WinT + 512 * 1024, 1024, nm, 1.f, 1, 0, 0);
            else if (k == 3) SETJ(win + 1552, 2576, 1024, 1024, WinT + 1536 * 1024, 1024, nm, 1.f, 1, 0, 0);
            else if (k == 4) SETJ(win + 1536, 2576, 1024, 16, WgT, 1024, nm, 1.f, 1, 0, 0);
            else if (k == 5) SETJ(a.in[8] + (size_t)e * MM, 1024, 1024, 1024, WoutT, 1024, nfp, 1.f, 1, 0, 0);
            else if (k == 6) SETJ(a.in[13] + (size_t)e * 16 * 4096, 64, 64, 64, LWT, 64, nfp, 1.f, 16, 4096, 4096);
            else SETJ(a.in[15] + (size_t)e * 16 * 4096, 64, 64, 64, LWT + 16 * 4096, 64, nfp, 1.f, 16, 4096, 4096);
        } else {
            const int o = (jid - 16) / 22, k = (jid - 16) % 22;
            unsigned char* wb = ws + OFF_WOD + o * 18 * MiB;
            bf16_t* Wrkv = (bf16_t*)wb; bf16_t* WoT = (bf16_t*)(wb + 14 * MiB); bf16_t* wlbT = (bf16_t*)(wb + 16 * MiB); bf16_t* albT = (bf16_t*)(wb + 16 * MiB + MiB / 4);
            bf16_t* gbT = (bf16_t*)(wb + 16 * MiB + MiB / 2); bf16_t* vlbT = (bf16_t*)(wb + 16 * MiB + 7 * MiB / 8);
            const float* mu = a.in[18] + (size_t)o * 6 * 1024;
            const int half = k & 1; const size_t koff = half ? 1024 : 0;
            if (k < 6) { const int w = k >> 1; const float* src = (w == 0 ? a.in[19] : (w == 1 ? a.in[20] : a.in[21])) + o * MM; const int mi = w == 0 ? 0 : (w == 1 ? 2 : 3);
                SETJ(src, 1024, 1024, 1024, Wrkv + (size_t)(1024 * w) * 2048 + koff, 2048, half ? mu + mi * 1024 : nfp, 1.f, 1, 0, 0); }
            else if (k < 8) SETJ(a.in[24] + (size_t)o * 2 * 65536, 64, 1024, 64, Wrkv + (size_t)3072 * 2048 + koff, 2048, half ? mu + 1 * 1024 : nfp, 1.f, 2, 65536, (size_t)64 * 2048);
            else if (k < 10) SETJ(a.in[27] + (size_t)o * 2 * 65536, 64, 1024, 64, Wrkv + (size_t)3200 * 2048 + koff, 2048, half ? mu + 4 * 1024 : nfp, 1.f, 2, 65536, (size_t)64 * 2048);
            else if (k < 12) SETJ(a.in[32] + (size_t)o * 1024 * 160, 160, 1024, 160, Wrkv + (size_t)3328 * 2048 + koff, 2048, half ? mu + 5 * 1024 : nfp, 1.f, 1, 0, 0);
            else if (k < 14) { if (o == 1) SETJ(a.in[30], 32, 1024, 32, Wrkv + (size_t)3488 * 2048 + koff, 2048, half ? mu + 3 * 1024 : nfp, 1.f, 1, 0, 0);
                               else SETJ(nfp, 0, 1024, 32, Wrkv + (size_t)3488 * 2048 + koff, 2048, nfp, 1.f, 1, 0, 0); }
            else if (k == 14) SETJ(nfp, 0, 2048, 64, Wrkv + (size_t)3520 * 2048, 2048, nfp, 1.f, 1, 0, 0);
            else if (k == 15) SETJ(a.in[22] + o * MM, 1024, 1024, 1024, WoT, 1024, nfp, 1.f, 1, 0, 0);
            else if (k == 16) SETJ(a.in[25] + (size_t)o * 2 * 65536, 1024, 64, 1024, wlbT, 64, nfp, 1.f, 2, 65536, 65536);
            else if (k == 17) SETJ(a.in[28] + (size_t)o * 2 * 65536, 1024, 64, 1024, albT, 64, nfp, 1.f, 2, 65536, 65536);
            else if (k == 18) SETJ(a.in[33] + (size_t)o * 160 * 1024, 1024, 160, 1024, gbT, 160, nfp, 1.f, 1, 0, 0);
            else if (k == 19 && o == 1) SETJ(a.in[31], 1024, 32, 1024, vlbT, 32, nfp, 1.f, 1, 0, 0);
            else ok = false;
        }
        if (ok) run_job(tl, jb, tb);
    }
}
__device__ __forceinline__ void cvt_ffn_weights(LAS float* tl, const Args& a, int Lr) {
    int tb = 0; unsigned char* ws = a.ws; const float* nfp = nullptr;
    bf16_t* WguT = (bf16_t*)(ws + OFF_WFFN); bf16_t* WdT = (bf16_t*)(ws + OFF_WFFN + 11 * MiB);
    const float* nf = a.in[2] + (size_t)Lr * 1024; const size_t WF = (size_t)1024 * 2816;
    for (int k = 0; k < 3; ++k) { Job jb;
        if (k == 0) SETJ(a.in[4] + Lr * WF, 2816, 1024, 128, WguT, 1024, nf, 1.f, 22, 128, (size_t)256 * 1024);
        else if (k == 1) SETJ(a.in[5] + Lr * WF, 2816, 1024, 128, WguT + 128 * 1024, 1024, nf, 1.f, 22, 128, (size_t)256 * 1024);
        else SETJ(a.in[6] + Lr * WF, 1024, 2816, 1024, WdT, 2816, nfp, 1.f, 1, 0, 0);
        run_job(tl, jb, tb); }
}

__device__ __forceinline__ void p0_rows(const float* x, float* X, bf16_t* XB, float* SS) {
    const int wid = otid() >> 6, lane = otid() & 63;
#pragma unroll 2
    for (int row = obid() * 8 + wid; row < T_; row += gridDim.x * 8) {
        const float* xr = x + (size_t)row * 1024; float ss = 0.f;
#pragma unroll
        for (int i = 0; i < 4; ++i) { const int col = i * 256 + lane * 4; const f32x4 v = *(const f32x4*)(xr + col); *(f32x4*)(X + (size_t)row * 1024 + col) = v;
            u32x2 w; w.x = cvt_pk_bf16(v[0], v[1]); w.y = cvt_pk_bf16(v[2], v[3]); *(u32x2*)(XB + (size_t)row * 1024 + col) = w;
            ss += (v[0] * v[0] + v[1] * v[1]) + (v[2] * v[2] + v[3] * v[3]); }
        ss = wave_sum(ss);
        if (lane < 16) SS[(size_t)row * 16 + lane] = lane == 0 ? ss : 0.f;
    }
}
__device__ __forceinline__ void final_rows(float* X, const float* SS, const float* nf) {
    const int wid = otid() >> 6, lane = otid() & 63;
#pragma unroll 2
    for (int row = obid() * 8 + wid; row < T_; row += gridDim.x * 8) {
        const float rs = rs_from_ss(SS, row);
#pragma unroll
        for (int i = 0; i < 4; ++i) { const int col = i * 256 + lane * 4; f32x4 v = *(const f32x4*)(X + (size_t)row * 1024 + col); const f32x4 g = *(const f32x4*)(nf + col);
            v = v * rs * g; *(f32x4*)(X + (size_t)row * 1024 + col) = v; }
    }
}

__device__ __forceinline__ void gates_gemm(const bf16_t* XB, const bf16_t* WgT, const float* SS, const float* bias, float* GATES) {
    const int wid = otid() >> 6, lane = otid() & 63, fr = lane & 15, fq = lane >> 4;
    for (int rt = obid() * 8 + wid; rt < T_ / 16; rt += gridDim.x * 8) {
        const size_t row = (size_t)rt * 16 + fr; f32x4 acc = {0.f, 0.f, 0.f, 0.f};
        const bf16_t* xr = XB + row * 1024 + 8 * fq; const bf16_t* wr = WgT + fr * 1024 + 8 * fq;
#pragma unroll 8
        for (int kk = 0; kk < 32; ++kk) { const bf16x8 xa = *(const bf16x8*)(xr + kk * 32), wb = *(const bf16x8*)(wr + kk * 32); acc = mma16(wb, xa, acc); }
        const float rs = rs_from_ss(SS, row); const f32x4 bv = *(const f32x4*)(bias + 4 * fq);
        *(f32x4*)(GATES + row * 16 + 4 * fq) = acc * rs + bv;
    }
}

__device__ __forceinline__ void ml_local(LAS unsigned char* L, const bf16_t* Z, const float* GATES, bf16_t* MLC, float* MLDN, float* MLG, float* MLA) {
    LAS bf16_t* Kt = (LAS bf16_t*)L; LAS bf16_t* Vt = Kt + 64 * 72; LAS float* wst = (LAS float*)(Vt + 128 * 72);
    const int tid = otid(), wid = tid >> 6, lane = tid & 63, fr = lane & 15, fq = lane >> 4;
    for (int item = obid(); item < 4096; item += gridDim.x) {
        const int chain = item >> 8, j = item & 255, g = chain >> 3, b = (chain >> 2) & 1, h = chain & 3;
        if (wid == 0) { const int s = 64 * j + lane, t = g ? (S_ - 1 - s) : s; const size_t row = (size_t)b * S_ + t;
            const float fpre = GATES[row * 16 + g * 8 + 4 + h], ipre = GATES[row * 16 + g * 8 + h];
            float bc = logsig(fpre);
            for (int o = 1; o < 64; o <<= 1) { const float v = __shfl_up(bc, o); if (lane >= o) bc += v; }
            const float gt = __shfl(bc, 63); const float ds = gt - bc + ipre; const float mx = wave_max(ds);
            wst[lane] = __expf(ds - mx);
            if (lane == 0) { MLG[item] = gt; MLA[item] = mx; } }
        __syncthreads();
        { const int i = tid >> 3, sg = tid & 7; const int s = 64 * j + i, t = g ? (S_ - 1 - s) : s; const bf16_t* zr = Z + ((size_t)b * S_ + t) * 2560;
            const bf16x8 kv = *(const bf16x8*)(zr + 256 + h * 64 + sg * 8);
#pragma unroll
            for (int e = 0; e < 8; ++e) Kt[(sg * 8 + e) * 72 + i] = (bf16_t)kv[e];
            const float w = wst[i];
#pragma unroll
            for (int hh = 0; hh < 2; ++hh) { const bf16x8 vv = *(const bf16x8*)(zr + 512 + h * 128 + (sg + 8 * hh) * 8);
#pragma unroll
                for (int e = 0; e < 8; ++e) Vt[((sg + 8 * hh) * 8 + e) * 72 + i] = f2bf(bfs2f(vv[e]) * w); } }
        __syncthreads();
        if (tid < 64) { float s = 0.f; for (int i = 0; i < 64; ++i) s += wst[i] * bf2f(Kt[tid * 72 + i]); MLDN[(size_t)item * 64 + tid] = s; }
        f32x4 acc[4];
#pragma unroll
        for (int td = 0; td < 4; ++td) acc[td] = (f32x4){0.f, 0.f, 0.f, 0.f};
#pragma unroll
        for (int kk = 0; kk < 2; ++kk) { const bf16x8 bv = lfrag(Vt, 72, wid * 16 + fr, kk * 32 + 8 * fq);
#pragma unroll
            for (int td = 0; td < 4; ++td) acc[td] = mma16(lfrag(Kt, 72, td * 16 + fr, kk * 32 + 8 * fq), bv, acc[td]); }
        bf16_t* out = MLC + (size_t)item * 8192 + (wid * 16 + fr) * 64 + 4 * fq;
#pragma unroll
        for (int td = 0; td < 4; ++td) { u32x2 w; w.x = cvt_pk_bf16(acc[td][0], acc[td][1]); w.y = cvt_pk_bf16(acc[td][2], acc[td][3]); *(u32x2*)(out + td * 16) = w; }
        __syncthreads();
    }
}
__device__ __forceinline__ void ml_combine(bf16_t* MLC, float* MLDN, const float* MLG, const float* MLA, float* MLM) {
    for (int id = obid() * 512 + otid(); id < 131072; id += gridDim.x * 512) {
        const int chain = id >> 13, el = id & 8191; const bool don = el < 64;
        float C = 0.f, m = 0.f, n = 0.f;
        for (int j0 = 0; j0 < 256; j0 += 16) {
            float d[16];
#pragma unroll
            for (int u = 0; u < 16; ++u) d[u] = bf2f(MLC[(size_t)(chain * 256 + j0 + u) * 8192 + el]);
#pragma unroll
            for (int u = 0; u < 16; ++u) { const int item = chain * 256 + j0 + u; const float g = MLG[item], am = MLA[item];
                MLC[(size_t)item * 8192 + el] = f2bf(C);
                float dn = 0.f; if (don) { dn = MLDN[(size_t)item * 64 + el]; MLDN[(size_t)item * 64 + el] = n; }
                if (el == 0) MLM[item] = m;
                const float mn = fmaxf(g + m, am), sc = __expf(g + m - mn), sd = __expf(am - mn);
                C = sc * C + sd * d[u]; n = sc * n + sd * dn; m = mn; }
        }
    }
}
__device__ __forceinline__ void ml_out(LAS unsigned char* L, const bf16_t* Z, const float* GATES, const bf16_t* MLC, const float* MLDN, const float* MLM, const float* gain, bf16_t* Y) {
    LAS bf16_t* Qs = (LAS bf16_t*)L; LAS bf16_t* Ks = Qs + 64 * 72; LAS bf16_t* Vt = Ks + 64 * 72; LAS bf16_t* Cs = Vt + 128 * 72; LAS bf16_t* Sm = Cs + 128 * 72; LAS bf16_t* Qw = Sm + 64 * 72;
    LAS float* Hacc = (LAS float*)(Qw + 64 * 72); LAS float* fl = Hacc + 64 * 132;
    LAS float* bcum = fl; LAS float* et = fl + 64; LAS float* Ms = fl + 128; LAS float* wint = fl + 192; LAS float* denp = fl + 256; LAS float* deni = fl + 384; LAS float* nv = fl + 448;
    const int tid = otid(), wid = tid >> 6, lane = tid & 63, fr = lane & 15, fq = lane >> 4;
    for (int item = obid(); item < 2048; item += gridDim.x) {
        const int b = item >> 10, h = (item >> 8) & 3, c = item & 255;
        for (int g = 0; g < 2; ++g) {
            const int j = g ? 255 - c : c, chain = g * 8 + b * 4 + h, it = chain * 256 + j;
            if (wid == 0) { const int t = g ? (64 * c + 63 - lane) : (64 * c + lane); const size_t row = (size_t)b * S_ + t;
                const float fpre = GATES[row * 16 + g * 8 + 4 + h], ipre = GATES[row * 16 + g * 8 + h];
                float bc = logsig(fpre);
                for (int o = 1; o < 64; o <<= 1) { const float v = __shfl_up(bc, o); if (lane >= o) bc += v; }
                const float e = ipre - bc; float cm = e;
                for (int o = 1; o < 64; o <<= 1) { const float v = __shfl_up(cm, o); if (lane >= o) cm = fmaxf(cm, v); }
                const float m = MLM[it], Mi = fmaxf(m, cm);
                bcum[lane] = bc; et[lane] = e; Ms[lane] = Mi; wint[lane] = __expf(m - Mi); nv[lane] = MLDN[(size_t)it * 64 + lane]; }
            { const int i = tid >> 3, sg = tid & 7; const int t = g ? (64 * c + 63 - i) : (64 * c + i); const bf16_t* zr = Z + ((size_t)b * S_ + t) * 2560;
                *(LAS bf16x8*)(Qs + i * 72 + sg * 8) = *(const bf16x8*)(zr + h * 64 + sg * 8);
                *(LAS bf16x8*)(Ks + i * 72 + sg * 8) = *(const bf16x8*)(zr + 256 + h * 64 + sg * 8);
#pragma unroll
                for (int hh = 0; hh < 2; ++hh) { const bf16x8 vv = *(const bf16x8*)(zr + 512 + h * 128 + (sg + 8 * hh) * 8);
#pragma unroll
                    for (int e = 0; e < 8; ++e) Vt[((sg + 8 * hh) * 8 + e) * 72 + i] = (bf16_t)vv[e]; }
#pragma unroll
                for (int hh = 0; hh < 2; ++hh) { const int idx = tid + 512 * hh, v = idx >> 3, s8 = idx & 7;
                    *(LAS bf16x8*)(Cs + v * 72 + s8 * 8) = *(const bf16x8*)(MLC + (size_t)it * 8192 + v * 64 + s8 * 8); } }
            __syncthreads();
            { const int i = tid >> 3, p = tid & 7; const float wi = wint[i]; float part = 0.f;
#pragma unroll
                for (int e = 0; e < 8; ++e) { const float q = bf2f(Qs[i * 72 + p * 8 + e]); Qw[i * 72 + p * 8 + e] = f2bf(q * wi); part += nv[p * 8 + e] * q; }
                part += __shfl_xor(part, 1); part += __shfl_xor(part, 2); part += __shfl_xor(part, 4);
                if (p == 0) deni[i] = part * wi; }
            { const int ti = wid >> 1, ts0 = (wid & 1) * 2; f32x4 acc[2] = {(f32x4){0.f, 0.f, 0.f, 0.f}, (f32x4){0.f, 0.f, 0.f, 0.f}};
#pragma unroll
                for (int kk = 0; kk < 2; ++kk) { const bf16x8 av = lfrag(Qs, 72, ti * 16 + fr, kk * 32 + 8 * fq);
#pragma unroll
                    for (int u = 0; u < 2; ++u) acc[u] = mma16(av, lfrag(Ks, 72, (ts0 + u) * 16 + fr, kk * 32 + 8 * fq), acc[u]); }
#pragma unroll
                for (int r = 0; r < 4; ++r) { const int i = ti * 16 + 4 * fq + r; const float Mi = Ms[i]; float rsum = 0.f;
#pragma unroll
                    for (int u = 0; u < 2; ++u) { const int s = (ts0 + u) * 16 + fr; const float val = (s <= i) ? acc[u][r] * __expf(et[s] - Mi) : 0.f; Sm[i * 72 + s] = f2bf(val); rsum += val; }
                    rsum = row16_sum(rsum); if (fr == 0) denp[i * 2 + (wid & 1)] = rsum; } }
            __syncthreads();
            { const int ti = wid >> 1, tv0 = (wid & 1) * 4; f32x4 acc[4];
#pragma unroll
                for (int u = 0; u < 4; ++u) acc[u] = (f32x4){0.f, 0.f, 0.f, 0.f};
#pragma unroll
                for (int kk = 0; kk < 2; ++kk) { const bf16x8 av = lfrag(Sm, 72, ti * 16 + fr, kk * 32 + 8 * fq);
#pragma unroll
                    for (int u = 0; u < 4; ++u) acc[u] = mma16(av, lfrag(Vt, 72, (tv0 + u) * 16 + fr, kk * 32 + 8 * fq), acc[u]); }
#pragma unroll
                for (int kk = 0; kk < 2; ++kk) { const bf16x8 av = lfrag(Qw, 72, ti * 16 + fr, kk * 32 + 8 * fq);
#pragma unroll
                    for (int u = 0; u < 4; ++u) acc[u] = mma16(av, lfrag(Cs, 72, (tv0 + u) * 16 + fr, kk * 32 + 8 * fq), acc[u]); }
#pragma unroll
                for (int r = 0; r < 4; ++r) { const int i = ti * 16 + 4 * fq + r; const float den = denp[2 * i] + denp[2 * i + 1] + deni[i];
                    const float dd = fmaxf(fabsf(den), __expf(-(bcum[i] + Ms[i]))), inv = 1.f / dd; const int tl = g ? 63 - i : i;
#pragma unroll
                    for (int u = 0; u < 4; ++u) { const int v = (tv0 + u) * 16 + fr; const float hv = acc[u][r] * inv; if (g == 0) Hacc[tl * 132 + v] = hv; else Hacc[tl * 132 + v] += hv; } } }
            __syncthreads();
        }
        { const int tok = tid >> 3, p = tid & 7; const size_t row = (size_t)b * S_ + 64 * c + tok; float ss = 0.f;
#pragma unroll
            for (int e = 0; e < 16; ++e) { const float hv = Hacc[tok * 132 + p * 16 + e]; ss += hv * hv; }
            ss += __shfl_xor(ss, 1); ss += __shfl_xor(ss, 2); ss += __shfl_xor(ss, 4);
            const float sc = rsqrtf(ss * (1.f / 128.f) + 1e-6f);
            const bf16_t* orow = Z + row * 2560 + 1024 + h * 128 + p * 16; bf16_t* yrow = Y + row * 1024 + h * 128 + p * 16; const float* gn = gain + h * 128 + p * 16;
#pragma unroll
            for (int hh = 0; hh < 2; ++hh) { const bf16x8 ov = *(const bf16x8*)(orow + hh * 8); float y[8];
#pragma unroll
                for (int e = 0; e < 8; ++e) y[e] = Hacc[tok * 132 + p * 16 + hh * 8 + e] * sc * gn[hh * 8 + e] * sigm(bfs2f(ov[e]));
                u32x4 w; w.x = cvt_pk_bf16(y[0], y[1]); w.y = cvt_pk_bf16(y[2], y[3]); w.z = cvt_pk_bf16(y[4], y[5]); w.w = cvt_pk_bf16(y[6], y[7]);
                *(u32x4*)(yrow + hh * 8) = w; } }
        __syncthreads();
    }
}

__device__ __forceinline__ void lru_pass(LAS unsigned char* L, int mode, const bf16_t* Z, const bf16_t* LWT, const float* conv_w, const float* conv_b, const float* b_a, const float* b_x, const float* lam,
                         float* LSUM, const float* LCAR, bf16_t* Y) {
    LAS float* xc = (LAS float*)L; LAS bf16_t* xcb = (LAS bf16_t*)(xc + 64 * 65); LAS bf16_t* LW = xcb + 64 * 72; LAS float* AA = (LAS float*)(LW + 4 * 64 * 72); LAS float* UU = AA + 2 * 64 * 65;
    const int tid = otid(), wid = tid >> 6, lane = tid & 63, fr = lane & 15, fq = lane >> 4;
    int nprev = -1;
    for (int item = obid(); item < 4096; item += gridDim.x) {
        const int b = item >> 11, seg = (item >> 3) & 255, n = item & 7;
        { LAS bf16_t* XS = (LAS bf16_t*)(L + 129280);
            for (int idx = tid; idx < 536; idx += 512) { const int rr = idx >> 3, sg = idx & 7, tt = seg * 64 - 2 + rr; bf16x8 v = (bf16x8){0, 0, 0, 0, 0, 0, 0, 0};
                if (tt >= 0 && tt < S_) v = *(const bf16x8*)(Z + ((size_t)b * S_ + tt) * 2560 + 1536 + n * 64 + sg * 8);
                *(LAS bf16x8*)(XS + rr * 72 + sg * 8) = v; }
            __syncthreads();
            const int d = tid & 63, ch = n * 64 + d; const float cw0 = conv_w[ch], cw1 = conv_w[512 + ch], cw2 = conv_w[1024 + ch], cw3 = conv_w[1536 + ch], cbv = conv_b[ch];
#pragma unroll
            for (int k8 = 0; k8 < 8; ++k8) { const int i = (tid >> 6) + 8 * k8;
                const float acc = cbv + bf2f(XS[i * 72 + d]) * cw0 + bf2f(XS[(i + 1) * 72 + d]) * cw1 + bf2f(XS[(i + 2) * 72 + d]) * cw2 + bf2f(XS[(i + 3) * 72 + d]) * cw3;
                xc[i * 65 + d] = acc; xcb[i * 72 + d] = f2bf(acc); } }
        if (n != nprev) { nprev = n;
        for (int idx = tid; idx < 2048; idx += 512) { const int mat = idx >> 9, d = (idx >> 3) & 63, sg = idx & 7, kind = mat >> 1, g = mat & 1;
            *(LAS bf16x8*)(LW + mat * 64 * 72 + d * 72 + sg * 8) = *(const bf16x8*)(LWT + (size_t)(kind * 16 + g * 8 + n) * 4096 + d * 64 + sg * 8); } }
        __syncthreads();
        { const int g = wid >> 2, ti = wid & 3; f32x4 aa[4], ax[4];
#pragma unroll
            for (int td = 0; td < 4; ++td) { aa[td] = (f32x4){0.f, 0.f, 0.f, 0.f}; ax[td] = (f32x4){0.f, 0.f, 0.f, 0.f}; }
#pragma unroll
            for (int kk = 0; kk < 2; ++kk) { const bf16x8 av = lfrag(xcb, 72, ti * 16 + fr, kk * 32 + 8 * fq);
#pragma unroll
                for (int td = 0; td < 4; ++td) { aa[td] = mma16(av, lfrag(LW + g * 64 * 72, 72, td * 16 + fr, kk * 32 + 8 * fq), aa[td]);
                    ax[td] = mma16(av, lfrag(LW + (2 + g) * 64 * 72, 72, td * 16 + fr, kk * 32 + 8 * fq), ax[td]); } }
#pragma unroll
            for (int td = 0; td < 4; ++td) { const int d = td * 16 + fr, ch = n * 64 + d; const float lm = lam[g * 512 + ch]; const float sp = lm > 0.f ? log1pf(expf(-lm)) : -lm + log1pf(expf(lm));
                const float ba_ = b_a[g * 512 + ch], bx_ = b_x[g * 512 + ch];
#pragma unroll
                for (int r = 0; r < 4; ++r) { const int i = ti * 16 + 4 * fq + r; const float la = -8.f * sigm(aa[td][r] + ba_) * sp;
                    const float a_ = __expf(la), x2 = 2.f * la; const float om = (x2 > -0.02f) ? -x2 * (1.f + x2 * (0.5f + x2 * (1.f / 6.f))) : 1.f - a_ * a_;
                    AA[g * 4160 + i * 65 + d] = a_; UU[g * 4160 + i * 65 + d] = __builtin_amdgcn_sqrtf(om) * sigm(ax[td][r] + bx_) * xc[i * 65 + d]; } } }
        __syncthreads();
        if (tid < 128) { const int g = tid >> 6, d = tid & 63, ch = n * 64 + d; const size_t ix = ((size_t)(b * 256 + seg) * 2 + g) * 512 + ch;
            if (mode == 0) { float P = 1.f, E = 0.f;
                for (int st = 0; st < 64; ++st) { const int i = g ? 63 - st : st; const float a_ = AA[g * 4160 + i * 65 + d]; E = a_ * E + UU[g * 4160 + i * 65 + d]; P *= a_; }
                LSUM[2 * ix] = P; LSUM[2 * ix + 1] = E; }
            else { float hc = LCAR[ix];
                for (int st = 0; st < 64; ++st) { const int i = g ? 63 - st : st; hc = AA[g * 4160 + i * 65 + d] * hc + UU[g * 4160 + i * 65 + d]; UU[g * 4160 + i * 65 + d] = hc; } } }
        __syncthreads();
        if (mode == 1) {
            { const int i = tid >> 3, sg = tid & 7; const size_t row = (size_t)b * S_ + seg * 64 + i;
                const bf16x8 gv = *(const bf16x8*)(Z + row * 2560 + 2048 + n * 64 + sg * 8); float y[8];
#pragma unroll
                for (int e = 0; e < 8; ++e) { const int d = sg * 8 + e; y[e] = (UU[i * 65 + d] + UU[4160 + i * 65 + d]) * gelu_tanh(bfs2f(gv[e])); }
                u32x4 w; w.x = cvt_pk_bf16(y[0], y[1]); w.y = cvt_pk_bf16(y[2], y[3]); w.z = cvt_pk_bf16(y[4], y[5]); w.w = cvt_pk_bf16(y[6], y[7]);
                *(u32x4*)(Y + row * 1024 + 512 + n * 64 + sg * 8) = w; }
            __syncthreads();
        }
    }
}
__device__ __forceinline__ void lru_carry(const float* __restrict__ LSUM, float* __restrict__ LCAR) {
    for (int id = obid() * 512 + otid(); id < 2048; id += gridDim.x * 512) {
        const int b = id >> 10, g = (id >> 9) & 1, ch = id & 511; float c = 0.f;
        for (int st = 0; st < 256; ++st) { const int seg = g ? 255 - st : st; const size_t ix = ((size_t)(b * 256 + seg) * 2 + g) * 512 + ch;
            LCAR[ix] = c; c = LSUM[2 * ix] * c + LSUM[2 * ix + 1]; }
    }
}

__device__ __forceinline__ void rw_mix(const float* X, const float* SS, const float* gm, bf16_t* AP) {
    const int wid = otid() >> 6, lane = otid() & 63;
#pragma unroll 2
    for (int row = obid() * 8 + wid; row < T_; row += gridDim.x * 8) {
        const int s = row & (S_ - 1); const bool hp = s > 0, hn = s < S_ - 1;
        const int which = lane >> 4; const bool valid = (which == 1) || (which == 0 && hp) || (which == 2 && hn);
        float v = valid ? SS[(size_t)(row - 1 + which) * 16 + (lane & 15)] : 0.f;
        v = row16_sum(v); const float rsv = rsqrtf(v * (1.f / 1024.f) + 1e-6f);
        const float rp = hp ? __shfl(rsv, 0) : 0.f, rc = __shfl(rsv, 16), rn = hn ? __shfl(rsv, 32) : 0.f;
#pragma unroll
        for (int i = 0; i < 4; ++i) { const int col = i * 256 + lane * 4; const f32x4 g4 = *(const f32x4*)(gm + col);
            const f32x4 xc4 = *(const f32x4*)(X + (size_t)row * 1024 + col);
            f32x4 xp4 = {0.f, 0.f, 0.f, 0.f}, xn4 = {0.f, 0.f, 0.f, 0.f};
            if (hp) xp4 = *(const f32x4*)(X + (size_t)(row - 1) * 1024 + col);
            if (hn) xn4 = *(const f32x4*)(X + (size_t)(row + 1) * 1024 + col);
            const f32x4 u = xc4 * rc * g4, up = xp4 * rp * g4, un = xn4 * rn * g4; const f32x4 xx = (up + un) * 0.5f - u;
            u32x2 w; w.x = cvt_pk_bf16(u[0], u[1]); w.y = cvt_pk_bf16(u[2], u[3]); *(u32x2*)(AP + (size_t)row * 2048 + col) = w;
            u32x2 w2; w2.x = cvt_pk_bf16(xx[0], xx[1]); w2.y = cvt_pk_bf16(xx[2], xx[3]); *(u32x2*)(AP + (size_t)row * 2048 + 1024 + col) = w2; }
    }
}

typedef float f32x2 __attribute__((ext_vector_type(2)));
#define RW_BAR() do { asm volatile("s_waitcnt lgkmcnt(0)" ::: "memory"); __builtin_amdgcn_s_barrier(); asm volatile("" ::: "memory"); } while (0)
__device__ __forceinline__ f32x4 unpk4(u32x2 w) { return (f32x4){__uint_as_float(w.x << 16), __uint_as_float(w.x & 0xffff0000u), __uint_as_float(w.y << 16), __uint_as_float(w.y & 0xffff0000u)}; }
__device__ __forceinline__ f32x4 sigm4(f32x4 x) { return (f32x4){sigm(x[0]), sigm(x[1]), sigm(x[2]), sigm(x[3])}; }
__device__ __forceinline__ f32x4 exp4(f32x4 x) { return (f32x4){__expf(x[0]), __expf(x[1]), __expf(x[2]), __expf(x[3])}; }
__device__ __forceinline__ u32x2 pk4(f32x4 x) { u32x2 w; w.x = cvt_pk_bf16(x[0], x[1]); w.y = cvt_pk_bf16(x[2], x[3]); return w; }
template <int CTRL> __device__ __forceinline__ float dpp0(float x) { return __builtin_bit_cast(float, __builtin_amdgcn_update_dpp(0, __builtin_bit_cast(int, x), CTRL, 0xf, 0xf, true)); }
__device__ __forceinline__ float row16_scan(float x) { x += dpp0<0x111>(x); x += dpp0<0x112>(x); x += dpp0<0x114>(x); x += dpp0<0x118>(x); return x; }
__device__ __forceinline__ bf16x8 pack8(f32x4 lo, f32x4 hi) { u32x4 w; w.x = cvt_pk_bf16(lo[0], lo[1]); w.y = cvt_pk_bf16(lo[2], lo[3]); w.z = cvt_pk_bf16(hi[0], hi[1]); w.w = cvt_pk_bf16(hi[2], hi[3]); return __builtin_bit_cast(bf16x8, w); }
__device__ __forceinline__ bf16x8 pack8il(f32x4 u, u32x2 vp) { const unsigned u01 = cvt_pk_bf16(u[0], u[1]), u23 = cvt_pk_bf16(u[2], u[3]); u32x4 w;
    w.x = (u01 & 0xffffu) | (vp.x << 16); w.y = (u01 >> 16) | (vp.x & 0xffff0000u); w.z = (u23 & 0xffffu) | (vp.y << 16); w.w = (u23 >> 16) | (vp.y & 0xffff0000u); return __builtin_bit_cast(bf16x8, w); }
__device__ __forceinline__ bf16x8 pack8v(f32x4 lo, u32x2 hi) { u32x4 w; w.x = cvt_pk_bf16(lo[0], lo[1]); w.y = cvt_pk_bf16(lo[2], lo[3]); w.z = hi.x; w.w = hi.y; return __builtin_bit_cast(bf16x8, w); }
__device__ __forceinline__ void rw_scan(LAS unsigned char* L, const bf16_t* Rg, const bf16_t* Kg, const bf16_t* Vg, const bf16_t* VF, const bf16_t* LO, const bf16_t* wlbT, const bf16_t* albT, const bf16_t* vlbT,
                        const float* w0, const float* a0, const float* v0, const float* k_k, const float* k_a, const float* r_k, bf16_t* WKV, float* BON2) {
    LAS bf16_t* BTw = (LAS bf16_t*)L; LAS bf16_t* BTa = BTw + 64 * 72; LAS bf16_t* BTv = BTa + 64 * 72;
    LAS float* CSTb = (LAS float*)(L + 23552);
    LAS bf16_t* BD = (LAS bf16_t*)(L + 25088); LAS bf16_t* KD = (LAS bf16_t*)(L + 34304);
    LAS float* MM = (LAS float*)(L + 43520);
    LAS bf16_t* OUTb = (LAS bf16_t*)(L + 48640);
    constexpr int SET0 = 53248, SETSZ = 52480;
    const int tid = otid(), wid = tid >> 6, lane = tid & 63, fr = lane & 15, fq = lane >> 4;
    const bool hasvf = VF != nullptr;
    const bf16x8 zero8 = (bf16x8){0, 0, 0, 0, 0, 0, 0, 0};
    for (int wk0 = obid(); wk0 < 256; wk0 += gridDim.x) {
        const int wk = ((wk0 & 7) << 5) | (wk0 >> 3);
        const int chain = wk >> 2, q = wk & 3, g = chain >> 5, b = (chain >> 4) & 1, h = chain & 15;
        { const int tid2 = otid(); const int d = tid2 >> 3, sg = tid2 & 7;
            *(LAS bf16x8*)(BTw + d * 72 + sg * 8) = *(const bf16x8*)(wlbT + ((size_t)g * 1024 + h * 64 + d) * 64 + sg * 8);
            *(LAS bf16x8*)(BTa + d * 72 + sg * 8) = *(const bf16x8*)(albT + ((size_t)g * 1024 + h * 64 + d) * 64 + sg * 8);
            if (hasvf && tid2 < 256) { const int d2 = tid2 >> 2, s2 = tid2 & 3; *(LAS bf16x8*)(BTv + d2 * 40 + s2 * 8) = *(const bf16x8*)(vlbT + (size_t)(h * 64 + d2) * 32 + s2 * 8); }
            if (tid2 < 384) { const int arr = tid2 >> 6, d3 = tid2 & 63, col = h * 64 + d3;
                float v = 0.f; if (arr == 0) v = w0[g * 1024 + col]; else if (arr == 1) v = hasvf ? v0[col] : 0.f; else if (arr == 2) v = a0[g * 1024 + col]; else if (arr == 3) v = k_k[col]; else if (arr == 4) v = k_a[col]; else v = r_k[col];
                CSTb[arr * 64 + d3] = v; }
            for (int idx = tid2; idx < 4096; idx += 512) { const int st = idx >> 11, w = idx & 2047;
                ((LAS unsigned*)(L + SET0 + st * SETSZ + (w < 1024 ? 35840 : 45056 - 4096)))[w] = 0u; } }
        __syncthreads();
        const int ti = wid & 3, half = wid >> 2;
        const int cb = h * 64 + 4 * fq;
        const bool hasv = (half == 1);
        bf16x8 flw0, flw1, fla0, fla1, flv = zero8; u32x2 xK[4], xR[2], xV = (u32x2){0u, 0u}, xVF = (u32x2){0u, 0u}; size_t rowg = 0;
#define RW_LOADS(n_) do { const int st_ = 64 * (n_) + ti * 16 + fr, t_ = g ? (S_ - 1 - st_) : st_; rowg = (size_t)b * S_ + t_; const bf16_t* lo_ = LO + rowg * 512; \
            flw0 = *(const bf16x8*)(lo_ + g * 64 + 8 * fq); flw1 = *(const bf16x8*)(lo_ + g * 64 + 32 + 8 * fq); fla0 = *(const bf16x8*)(lo_ + 128 + g * 64 + 8 * fq); fla1 = *(const bf16x8*)(lo_ + 128 + g * 64 + 32 + 8 * fq); \
            if (hasvf && hasv) flv = *(const bf16x8*)(lo_ + 416 + 8 * fq); \
            _Pragma("unroll") for (int td = 0; td < 4; ++td) xK[td] = *(const u32x2*)(Kg + rowg * 1024 + cb + td * 16); \
            _Pragma("unroll") for (int tl = 0; tl < 2; ++tl) xR[tl] = *(const u32x2*)(Rg + rowg * 1024 + cb + (2 * half + tl) * 16); \
            if (hasv) { xV = *(const u32x2*)(Vg + rowg * 1024 + cb + q * 16); if (hasvf) xVF = *(const u32x2*)(VF + rowg * 1024 + cb + q * 16); } } while (0)
        RW_LOADS(0);
        f32x4 ST[4];
#pragma unroll
        for (int kt = 0; kt < 4; ++kt) ST[kt] = (f32x4){0.f, 0.f, 0.f, 0.f};
#pragma unroll 2
        for (int m = 0; m < 258; ++m) {
            LAS unsigned char* setp = L + SET0 + (m & 1) * SETSZ;
            LAS bf16_t* KQ = (LAS bf16_t*)setp; LAS bf16_t* RQ = (LAS bf16_t*)(setp + 9216); LAS bf16_t* W2 = (LAS bf16_t*)(setp + 18432); LAS bf16_t* NA = (LAS bf16_t*)(setp + 35840);
            LAS bf16_t* AR = (LAS bf16_t*)(setp + 39936); LAS bf16_t* TI = (LAS bf16_t*)(setp + 45056); LAS float* LLs = (LAS float*)(setp + 49152); LAS bf16_t* Vt = (LAS bf16_t*)(setp + 50176);
            if (wid == 0) __builtin_amdgcn_s_setprio(3);
            if (wid == 0) {
                if (m >= 1 && m <= 256) {
                    LAS unsigned char* sp = L + SET0 + ((m - 1) & 1) * SETSZ;
                    const LAS bf16_t* cKQ = (const LAS bf16_t*)sp; const LAS bf16_t* cRQ = (const LAS bf16_t*)(sp + 9216); const LAS bf16_t* cW2 = (const LAS bf16_t*)(sp + 18432); const LAS bf16_t* cNA = (const LAS bf16_t*)(sp + 35840);
                    const LAS bf16_t* cAR = (const LAS bf16_t*)(sp + 39936); const LAS bf16_t* cTI = (const LAS bf16_t*)(sp + 45056); const LAS float* cLL = (const LAS float*)(sp + 49152); const LAS bf16_t* cVt = (const LAS bf16_t*)(sp + 50176);
                    LAS bf16_t* ob = OUTb + ((m - 1) & 1) * (64 * 18);
                    const f32x4 z4 = {0.f, 0.f, 0.f, 0.f};
#pragma unroll 2
                    for (int sc = 0; sc < 4; ++sc) {
                        const bf16x8 s01 = pack8(ST[0], ST[1]), s23 = pack8(ST[2], ST[3]);
                        const u32x2 vp = *(const LAS u32x2*)(cVt + fr * 72 + sc * 16 + 4 * fq);
                        f32x4 X = mma16(lfrag(cKQ, 72, sc * 16 + fr, 8 * fq), s01, z4); X = mma16(lfrag(cKQ, 72, sc * 16 + fr, 32 + 8 * fq), s23, X);
                        X = mma16(lfrag(cNA, 32, sc * 16 + fr, 8 * fq), pack8v(z4, vp), X);
                        const f32x4 U = mma16(lfrag(cTI, 32, sc * 16 + fr, 8 * fq), pack8(X, z4), z4);
                        const bf16x8 uv = pack8il(U, vp);
                        f32x4 O = mma16(lfrag(cRQ, 72, sc * 16 + fr, 8 * fq), s01, z4); O = mma16(lfrag(cRQ, 72, sc * 16 + fr, 32 + 8 * fq), s23, O);
#pragma unroll
                        for (int kt = 0; kt < 4; ++kt) { const f32x4 ll = *(const LAS f32x4*)(cLL + sc * 64 + kt * 16 + 4 * fq);
                            ST[kt] = mma16(lfrag(cW2, 136, kt * 16 + fr, sc * 32 + 8 * fq), uv, ST[kt] * ll); }
                        O = mma16(lfrag(cAR, 40, sc * 16 + fr, 8 * fq), uv, O);
#pragma unroll
                        for (int r = 0; r < 4; ++r) ob[(sc * 16 + 4 * fq + r) * 18 + fr] = f2bf(O[r]);
                    }
                }
            }
            if (m < 256) {
                const size_t rowcur = rowg; const int irow = ti * 16 + fr;
                f32x4 accw[2], acca[2], accv = (f32x4){0.f, 0.f, 0.f, 0.f};
#pragma unroll
                for (int tl = 0; tl < 2; ++tl) { const int td = 2 * half + tl; accw[tl] = (f32x4){0.f, 0.f, 0.f, 0.f}; acca[tl] = (f32x4){0.f, 0.f, 0.f, 0.f};
                    accw[tl] = mma16(lfrag(BTw, 72, td * 16 + fr, 8 * fq), flw0, accw[tl]); accw[tl] = mma16(lfrag(BTw, 72, td * 16 + fr, 32 + 8 * fq), flw1, accw[tl]);
                    acca[tl] = mma16(lfrag(BTa, 72, td * 16 + fr, 8 * fq), fla0, acca[tl]); acca[tl] = mma16(lfrag(BTa, 72, td * 16 + fr, 32 + 8 * fq), fla1, acca[tl]); }
                if (hasvf && hasv) accv = mma16(lfrag(BTv, 40, q * 16 + fr, 8 * fq), flv, accv);
                float n2 = 0.f;
#pragma unroll
                for (int td = 0; td < 4; ++td) { const f32x4 kk_ = unpk4(xK[td]) * *(const LAS f32x4*)(CSTb + 192 + td * 16 + 4 * fq); n2 += (kk_[0] * kk_[0] + kk_[1] * kk_[1]) + (kk_[2] * kk_[2] + kk_[3] * kk_[3]); }
                n2 += __shfl_xor(n2, 16); n2 += __shfl_xor(n2, 32);
                const float inv = fminf(__builtin_amdgcn_rsqf(n2), 1e12f);
                const f32x4 krs0 = unpk4(half ? xK[2] : xK[0]), krs1 = unpk4(half ? xK[3] : xK[1]), r4s0 = unpk4(xR[0]), r4s1 = unpk4(xR[1]); const f32x4 v4u = unpk4(xV), vf4u = unpk4(xVF);
                asm volatile("" ::: "memory");
                if (m + 1 < 256) RW_LOADS(m + 1);
                float bs = 0.f;
#pragma unroll
                for (int tl = 0; tl < 2; ++tl) { const int td = 2 * half + tl; const int c4 = td * 16 + 4 * fq;
                    const f32x4 lw = sigm4(*(const LAS f32x4*)(CSTb + c4) + accw[tl]) * (-0.6065306597126334f * 1.4426950408889634f);
                    f32x4 cl;
#pragma unroll
                    for (int r = 0; r < 4; ++r) cl[r] = row16_scan(lw[r]);
                    const f32x4 ep = (f32x4){__builtin_amdgcn_exp2f(cl[0]), __builtin_amdgcn_exp2f(cl[1]), __builtin_amdgcn_exp2f(cl[2]), __builtin_amdgcn_exp2f(cl[3])};
                    f32x4 epL, em, en;
#pragma unroll
                    for (int r = 0; r < 4; ++r) { epL[r] = __shfl(ep[r], (lane & 48) | 15); const float sh = dpp0<0x111>(ep[r]); em[r] = (fr == 0) ? 1.f : sh; en[r] = __builtin_amdgcn_rcpf(ep[r]); }
                    const f32x4 eL = epL * en;
                    const f32x4 a4 = sigm4(*(const LAS f32x4*)(CSTb + 128 + c4) + acca[tl]);
                    const f32x4 kr = tl ? krs1 : krs0; const f32x4 kk4 = kr * *(const LAS f32x4*)(CSTb + 192 + c4) * inv;
                    const f32x4 kd4 = kr * (1.f + (a4 - 1.f) * *(const LAS f32x4*)(CSTb + 256 + c4)); const f32x4 b4 = kk4 * a4; const f32x4 r4 = tl ? r4s1 : r4s0;
                    if (ti == q) { const f32x4 rk = r4 * kd4 * *(const LAS f32x4*)(CSTb + 320 + c4); bs += (rk[0] + rk[1]) + (rk[2] + rk[3]); }
                    const int p4 = 32 * (td >> 1) + 8 * fq + 4 * (td & 1);
                    *(LAS u32x2*)(KQ + irow * 72 + p4) = pk4(kk4 * em); *(LAS u32x2*)(RQ + irow * 72 + p4) = pk4(r4 * ep);
                    *(LAS u32x2*)(BD + irow * 72 + p4) = pk4(b4 * en); *(LAS u32x2*)(KD + irow * 72 + p4) = pk4(kd4 * en);
                    const f32x4 bl = b4 * eL, kl = kd4 * eL;
#pragma unroll
                    for (int r = 0; r < 4; ++r) *(LAS unsigned*)(W2 + (c4 + r) * 136 + ti * 32 + 8 * (fr >> 2) + 2 * (fr & 3)) = cvt_pk_bf16(bl[r], kl[r]);
                    if (fr == 15) *(LAS f32x4*)(LLs + ti * 64 + c4) = epL;
                }
                if (ti == q) { bs += __shfl_xor(bs, 16); bs += __shfl_xor(bs, 32);
                    if (fq == 0) BON2[((size_t)(g * 2 + half) * T_ + rowcur) * 16 + h] = bs; }
                if (hasv) { f32x4 v4 = v4u;
                    if (hasvf) { const f32x4 vf4 = vf4u; v4 = v4 + (vf4 - v4) * sigm4(*(const LAS f32x4*)(CSTb + 64 + q * 16 + 4 * fq) + accv); }
#pragma unroll
                    for (int r = 0; r < 4; ++r) Vt[(4 * fq + r) * 72 + irow] = f2bf(v4[r]); }
            }
            if (wid == 0) __builtin_amdgcn_s_setprio(0);
            if (m >= 2) {
                const LAS bf16_t* ob = OUTb + (m & 1) * (64 * 18);
                const int i = tid >> 3, rr = (tid & 7) * 2; const int st = 64 * (m - 2) + i, t = g ? (S_ - 1 - st) : st; const size_t row = (size_t)b * S_ + t;
                *(unsigned*)(WKV + ((size_t)g * T_ + row) * 1024 + h * 64 + 16 * q + rr) = *(const LAS unsigned*)(ob + i * 18 + rr);
            }
            RW_BAR();
            if (m < 256) { const int sc = wid >> 1;
#pragma unroll
                for (int ml = 0; ml < 3; ++ml) { const int mat = (wid & 1) ? ml + 1 : 0; if ((wid & 1) == 0 && ml > 0) break;     const LAS bf16_t* Am = (mat < 2) ? KQ : RQ; const LAS bf16_t* Bm = (mat & 1) ? KD : BD;
                    f32x4 acc = {0.f, 0.f, 0.f, 0.f};
                    acc = mma16(lfrag(Am, 72, sc * 16 + fr, 8 * fq), lfrag(Bm, 72, sc * 16 + fr, 8 * fq), acc);
                    acc = mma16(lfrag(Am, 72, sc * 16 + fr, 32 + 8 * fq), lfrag(Bm, 72, sc * 16 + fr, 32 + 8 * fq), acc);
#pragma unroll
                    for (int r = 0; r < 4; ++r) { const int t = 4 * fq + r, sidx = fr; const bool keep = (mat < 2) ? (sidx < t) : (sidx <= t); const float val = keep ? acc[r] : 0.f;
                        if (mat == 0) MM[(sc * 16 + t) * 20 + sidx] = val;
                        else if (mat == 1) NA[(sc * 16 + t) * 32 + 8 * (sidx >> 2) + 4 + (sidx & 3)] = f2bf(val);
                        else if (mat == 2) AR[(sc * 16 + t) * 40 + 8 * (sidx >> 2) + 2 * (sidx & 3)] = f2bf(val);
                        else AR[(sc * 16 + t) * 40 + 8 * (sidx >> 2) + 2 * (sidx & 3) + 1] = f2bf(val); } }
                if ((wid & 1) == 0) { asm volatile("" ::: "memory");
                    const int c = lane & 15; float tcol[16];
#pragma unroll
                    for (int i = 0; i < 16; ++i) { float acc0 = (i == c) ? 1.f : 0.f, acc1 = 0.f;
#pragma unroll
                        for (int j4 = 0; j4 < 4; ++j4) { if (j4 * 4 < i) { const f32x4 m4 = *(const LAS f32x4*)(MM + (sc * 16 + i) * 20 + j4 * 4);
#pragma unroll
                                for (int jr = 0; jr < 4; ++jr) { const int j = j4 * 4 + jr; if (j < i) { if (jr & 1) acc1 -= m4[jr] * tcol[j]; else acc0 -= m4[jr] * tcol[j]; } } } }
                        tcol[i] = acc0 + acc1; }
                    if (lane < 16) {
#pragma unroll
                        for (int i = 0; i < 16; ++i) TI[(sc * 16 + i) * 32 + 8 * (c >> 2) + (c & 3)] = f2bf(-tcol[i]); } }
            }
            RW_BAR();
        }
#undef RW_LOADS
        __syncthreads();
    }
}

__device__ __forceinline__ void rw_post(const bf16_t* Vg, const bf16_t* VF, const bf16_t* LO, const bf16_t* gbT, const bf16_t* vlbT, const float* v0, const bf16_t* WKV, const float* BON, const float* ln_w, const float* ln_b, bf16_t* Y, bf16_t* VFout) {
    const int tid = otid(), wid = tid >> 6, lane = tid & 63, fr = lane & 15, fq = lane >> 4;
    const bool hasvf = VF != nullptr;
    int hprev = -1;
    bf16x8 gbf[4][5], vlf[4];
#pragma unroll
    for (int td = 0; td < 4; ++td) { vlf[td] = (bf16x8){0, 0, 0, 0, 0, 0, 0, 0};
#pragma unroll
        for (int kk = 0; kk < 5; ++kk) gbf[td][kk] = vlf[td]; }
    for (int item = obid(); item < 4096; item += gridDim.x) {
        const int tile = item >> 4, h = item & 15; const int cb = h * 64 + 4 * fq;
        if (h != hprev) { hprev = h;
#pragma unroll
            for (int td = 0; td < 4; ++td) {
#pragma unroll
                for (int kk = 0; kk < 5; ++kk) gbf[td][kk] = *(const bf16x8*)(gbT + (size_t)(h * 64 + td * 16 + fr) * 160 + kk * 32 + 8 * fq);
                if (hasvf) vlf[td] = *(const bf16x8*)(vlbT + (size_t)(h * 64 + td * 16 + fr) * 32 + 8 * fq); } }
        const size_t row = (size_t)tile * 128 + wid * 16 + fr;
        const bf16_t* lo = LO + row * 512;
        bf16x8 lf[5], lvf = (bf16x8){0, 0, 0, 0, 0, 0, 0, 0};
#pragma unroll
        for (int kk = 0; kk < 5; ++kk) lf[kk] = *(const bf16x8*)(lo + 256 + kk * 32 + 8 * fq);
        if (hasvf) lvf = *(const bf16x8*)(lo + 416 + 8 * fq);
        u32x2 w0[4], w1[4], vv[4], vf[4];
#pragma unroll
        for (int td = 0; td < 4; ++td) { w0[td] = *(const u32x2*)(WKV + row * 1024 + cb + td * 16); w1[td] = *(const u32x2*)(WKV + ((size_t)T_ + row) * 1024 + cb + td * 16);
            vv[td] = *(const u32x2*)(Vg + row * 1024 + cb + td * 16); vf[td] = hasvf ? *(const u32x2*)(VF + row * 1024 + cb + td * 16) : (u32x2){0u, 0u}; }
        const float bon = (BON[row * 16 + h] + BON[((size_t)T_ + row) * 16 + h]) + (BON[((size_t)2 * T_ + row) * 16 + h] + BON[((size_t)3 * T_ + row) * 16 + h]);
        f32x4 acc[4], accv[4];
#pragma unroll
        for (int td = 0; td < 4; ++td) { acc[td] = (f32x4){0.f, 0.f, 0.f, 0.f}; accv[td] = (f32x4){0.f, 0.f, 0.f, 0.f};
#pragma unroll
            for (int kk = 0; kk < 5; ++kk) acc[td] = mma16(gbf[td][kk], lf[kk], acc[td]);
            if (hasvf) accv[td] = mma16(vlf[td], lvf, accv[td]); }
        f32x4 wk[4]; float sum = 0.f;
#pragma unroll
        for (int td = 0; td < 4; ++td) { wk[td] = unpk4(w0[td]) + unpk4(w1[td]); sum += (wk[td][0] + wk[td][1]) + (wk[td][2] + wk[td][3]); }
        sum += __shfl_xor(sum, 16); sum += __shfl_xor(sum, 32);
        const float mean = sum * (1.f / 64.f); float vs = 0.f;
#pragma unroll
        for (int td = 0; td < 4; ++td) { const f32x4 dd = wk[td] - mean; vs += (dd[0] * dd[0] + dd[1] * dd[1]) + (dd[2] * dd[2] + dd[3] * dd[3]); }
        vs += __shfl_xor(vs, 16); vs += __shfl_xor(vs, 32);
        const float rstd = rsqrtf(vs * (1.f / 64.f) + 64e-5f);
#pragma unroll
        for (int td = 0; td < 4; ++td) { f32x4 v4 = unpk4(vv[td]);
            if (hasvf) { const f32x4 vf4 = unpk4(vf[td]); v4 = v4 + (vf4 - v4) * sigm4(*(const f32x4*)(v0 + cb + td * 16) + accv[td]); }
            else *(u32x2*)(VFout + row * 1024 + cb + td * 16) = vv[td];
            const f32x4 y = ((wk[td] - mean) * rstd * *(const f32x4*)(ln_w + cb + td * 16) + *(const f32x4*)(ln_b + cb + td * 16) + v4 * bon) * acc[td];
            *(u32x2*)(Y + row * 1024 + cb + td * 16) = pk4(y); }
    }
}

#define XB_TMO      128
#define XB_XCNT(j)  (256  + 64 * (j))
#define XB_XSUB(j)  (1280 + 64 * (j))
#define XB_XGEN(j)  (2304 + 64 * (j))
#define XB_TOP      3328
#define XB_TOPGEN   3392
#define XCD_BAR_WORDS 3456
#define XB_SPIN_CAP (1u << 22)
__device__ __forceinline__ unsigned xb_ld(unsigned* p)              { return __hip_atomic_load(p, __ATOMIC_RELAXED, __HIP_MEMORY_SCOPE_AGENT); }
__device__ __forceinline__ unsigned xb_add(unsigned* p, unsigned v) { return __hip_atomic_fetch_add(p, v, __ATOMIC_RELAXED, __HIP_MEMORY_SCOPE_AGENT); }
__device__ __forceinline__ unsigned xb_xcc_id() { return (unsigned)__builtin_amdgcn_s_getreg((3 << 11) | 20) & 0xFu; }
#define XB_SPIN(cond, bar) do { unsigned _sp = 0; while (cond) { __builtin_amdgcn_s_sleep(1); \
    if ((++_sp & 255u) == 0u) { if (xb_ld(&(bar)[XB_TMO])) break; if (_sp > XB_SPIN_CAP) { atomicAdd(&(bar)[XB_TMO], 1u); break; } } } } while (0)
struct XcdBarrier { unsigned* bar; unsigned x; volatile LAS unsigned* st; };
__device__ __forceinline__ XcdBarrier xcd_barrier_post(unsigned* bar, volatile LAS unsigned* st) {
    XcdBarrier b; b.bar = bar; b.x = xb_xcc_id(); b.st = st;
    if (__builtin_amdgcn_workitem_id_x() == 0) (void)xb_add(&bar[XB_XCNT(b.x)], 1u);
    return b;
}
__device__ __forceinline__ void xcd_barrier_complete(unsigned* bar, unsigned x, unsigned& nloc, unsigned& nx) {
    const unsigned G = gridDim.x * gridDim.y * gridDim.z;
    unsigned sum, cnt, mine, sp = 0u;
    for (;;) {
        sum = 0u; cnt = 0u; mine = 0u;
#pragma unroll
        for (unsigned j = 0; j < 16; ++j) { const unsigned c = xb_ld(&bar[XB_XCNT(j)]); sum += c; cnt += (c > 0u) ? 1u : 0u; mine = (j == x) ? c : mine; }
        if (sum == G) break;
        __builtin_amdgcn_s_sleep(1);
        if ((++sp & 255u) == 0u) { if (xb_ld(&bar[XB_TMO])) break; if (sp > XB_SPIN_CAP) { atomicAdd(&bar[XB_TMO], 1u); break; } }
    }
    nloc = mine > 0u ? mine : 1u; nx = cnt > 0u ? cnt : 1u;
}
__device__ __forceinline__ void xcd_barrier(const XcdBarrier& b) {
    asm volatile("s_waitcnt vmcnt(0)" ::: "memory");
    __syncthreads();
    if (__builtin_amdgcn_workitem_id_x() == 0) {
        unsigned* bar = b.bar;
        __builtin_amdgcn_s_waitcnt(0);
        unsigned nloc = b.st[0], nx = b.st[1];
        if (nloc == 0u) { xcd_barrier_complete(bar, b.x, nloc, nx); b.st[0] = nloc; b.st[1] = nx; }
        const unsigned old = xb_add(&bar[XB_XSUB(b.x)], 1u);
        const unsigned gen = old / nloc;
        if (old + 1u == (gen + 1u) * nloc) {
            __builtin_amdgcn_fence(__ATOMIC_RELEASE, "agent");
            asm volatile("s_waitcnt vmcnt(0)" ::: "memory");
            const unsigned og = xb_add(&bar[XB_TOP], 1u);
            const unsigned tg = og / nx;
            if (og + 1u == (tg + 1u) * nx) xb_add(&bar[XB_TOPGEN], 1u);
            else XB_SPIN(xb_ld(&bar[XB_TOPGEN]) == tg, bar);
            __builtin_amdgcn_fence(__ATOMIC_ACQUIRE, "agent");
            xb_add(&bar[XB_XGEN(b.x)], 1u);
            asm volatile("s_waitcnt vmcnt(0)" ::: "memory");
        } else {
            XB_SPIN(xb_ld(&bar[XB_XGEN(b.x)]) == gen, bar);
            __builtin_amdgcn_fence(__ATOMIC_ACQUIRE, "agent");
            asm volatile("s_waitcnt vmcnt(0)" ::: "memory");
        }
    }
    __syncthreads();
}

__global__ void __launch_bounds__(512) mega(Args a) {
    extern __shared__ __attribute__((aligned(16))) unsigned char lds_raw[];
    LAS unsigned char* L = (LAS unsigned char*)lds_raw;
    cg::grid_group grid = cg::this_grid();
    unsigned char* ws = a.ws;
    float* X = a.out;
    float* SS = (float*)(ws + OFF_SS); float* GATES = (float*)(ws + OFF_GATES); float* LSUM = (float*)(ws + OFF_LSUM); float* LCAR = (float*)(ws + OFF_LCAR); float* BON = (float*)(ws + OFF_LSUM);
    float* MLG = (float*)(ws + OFF_MLAUX); float* MLA = MLG + 4096; float* MLM = MLA + 4096; float* MLDN = (float*)(ws + OFF_MLAUX + MiB);
    bf16_t* bufA = (bf16_t*)(ws + OFF_XB); bf16_t* bufB = (bf16_t*)(ws + OFF_XB + 64 * MiB); bf16_t* VFb = (bf16_t*)(ws + OFF_VF);
    bf16_t* Zb = (bf16_t*)(ws + OFF_BIG); bf16_t* MLC = (bf16_t*)(ws + OFF_BIG + 160 * MiB); bf16_t* HB = (bf16_t*)(ws + OFF_BIG);
    bf16_t* Rb = (bf16_t*)(ws + OFF_BIG); bf16_t* Kb = (bf16_t*)(ws + OFF_BIG + 64 * MiB); bf16_t* Vb3 = (bf16_t*)(ws + OFF_BIG + 128 * MiB); bf16_t* LOb = (bf16_t*)(ws + OFF_BIG + 192 * MiB);
    bf16_t* WguT = (bf16_t*)(ws + OFF_WFFN); bf16_t* WdT = (bf16_t*)(ws + OFF_WFFN + 11 * MiB);
    const int G = gridDim.x;
    volatile LAS unsigned* bst = (volatile LAS unsigned*)(L + LDS_BYTES - 16);
    if (otid() < 4) bst[otid()] = 0u;
    __syncthreads();
    const XcdBarrier xbar = xcd_barrier_post((unsigned*)(ws + OFF_BAR), bst);

    for (int p = a.ph_lo; p < a.ph_hi; ++p) {
        if (p == 0) {
#ifndef NO_P0
            p0_rows(a.in[0], X, bufA, SS);
#endif
#ifndef NO_P0
            cvt_mixer_weights((LAS float*)L, a);
#endif
        } else if (p == 29) {
#ifndef NO_P0
            final_rows(X, SS, a.in[3]);
#endif
        } else {
            const int Lr = (p - 1) / 7, s = (p - 1) % 7, odd = Lr & 1, e = Lr >> 1, o = Lr >> 1;
            unsigned char* wev = ws + OFF_WEV + e * 8 * MiB; unsigned char* wod = ws + OFF_WOD + o * 18 * MiB;
            if (s == 4 || s == 6) {
                pg8::Gemm gm; gm.M = T_; gm.N = 1024;
                if (s == 6) { gm.A = HB; gm.Bt = WdT; gm.K = 2816; }
                else if (!odd) { gm.A = bufB; gm.Bt = (const bf16_t*)(wev + 5 * MiB + MiB / 4); gm.K = 1024; }
                else { gm.A = Rb; gm.Bt = (const bf16_t*)(wod + 14 * MiB); gm.K = 1024; }
                pg8::StaticOrder So; So.init(T_, 1024, G, obid());
                pg8::EpiRes E; E.X = X; E.XB = bufA; E.SS = SS;
#ifndef NO_G1
                pg8::gemm_phase<pg8::EpiRes>(L, gm, So, E);
#endif
            } else if (s == 5) {
                pg8::Gemm gm; gm.A = bufA; gm.Bt = WguT; gm.M = T_; gm.N = 5632; gm.K = 1024;
                pg8::StaticOrder So; So.init(T_, 5632, G, obid());
                pg8::EpiSwi E; E.Hp = HB; E.SS = SS;
#ifndef NO_G2
                pg8::gemm_phase<pg8::EpiSwi>(L, gm, So, E);
#endif
            } else if (!odd) {
                const bf16_t* LWT = (const bf16_t*)(wev + 7 * MiB + MiB / 4);
                if (s == 0) {
                    pg8::Gemm gm; gm.A = bufA; gm.Bt = (const bf16_t*)wev; gm.M = T_; gm.N = 2560; gm.K = 1024;
                    pg8::StaticOrder So; So.init(T_, 2560, G, obid());
                    pg8::EpiZ E; E.Zp = Zb; E.SS = SS;
#ifndef NO_G3
                    pg8::gemm_phase<pg8::EpiZ>(L, gm, So, E);
#endif
#ifndef NO_ML
                    gates_gemm(bufA, (const bf16_t*)(wev + 5 * MiB), SS, a.in[9] + e * 16, GATES);
#endif
                } else if (s == 2) {
#ifndef NO_ML
                    ml_combine(MLC, MLDN, MLG, MLA, MLM);
#endif
#ifndef NO_ML
                    lru_carry(LSUM, LCAR);
#endif
                } else {
#ifndef NO_MLL
                    if (s == 1) ml_local(L, Zb, GATES, MLC, MLDN, MLG, MLA);
                    else ml_out(L, Zb, GATES, MLC, MLDN, MLM, a.in[10] + e * 512, bufB);
#endif
#ifndef NO_LRU
                    lru_pass(L, s == 3 ? 1 : 0, Zb, LWT, a.in[11] + e * 2048, a.in[12] + e * 512, a.in[14] + e * 1024, a.in[16] + e * 1024, a.in[17] + e * 1024, LSUM, LCAR, bufB);
#endif
                }
            } else {
                const bf16_t* VF = o == 0 ? (const bf16_t*)nullptr : (const bf16_t*)VFb;
                const bf16_t* wlbT = (const bf16_t*)(wod + 16 * MiB); const bf16_t* albT = (const bf16_t*)(wod + 16 * MiB + MiB / 4);
                const bf16_t* gbT = (const bf16_t*)(wod + 16 * MiB + MiB / 2); const bf16_t* vlbT = (const bf16_t*)(wod + 16 * MiB + 7 * MiB / 8);
                if (s == 0) {
#ifndef NO_RW
                    rw_mix(X, SS, a.in[1] + Lr * 1024, bufA);
#endif
                } else if (s == 1) {
                    pg8::Gemm gm; gm.A = bufA; gm.Bt = (const bf16_t*)wod; gm.M = T_; gm.N = 3584; gm.K = 2048;
                    pg8::StaticOrder So; So.init(T_, 3584, G, obid());
                    pg8::EpiRKV E; E.Rp = Rb;
#ifndef NO_G4
                    pg8::gemm_phase<pg8::EpiRKV>(L, gm, So, E);
#endif
                } else if (s == 2) {
#ifndef NO_SCAN
                    rw_scan(L, Rb, Kb, Vb3, VF, LOb, wlbT, albT, vlbT, a.in[23] + o * 2048, a.in[26] + o * 2048, a.in[29], a.in[34] + o * 1024, a.in[35] + o * 1024, a.in[36] + o * 1024, bufA, BON);
#endif
                } else {
#ifndef NO_RW
                    rw_post(Vb3, VF, LOb, gbT, vlbT, a.in[29], bufA, BON, a.in[37] + o * 1024, a.in[38] + o * 1024, Rb, VFb);
#endif
                }
            }
#ifndef NO_P0
            if (s == 1) cvt_ffn_weights((LAS float*)L, a, Lr);
#endif
        }
        if (p + 1 < a.ph_hi) { if (p == 0) grid.sync(); else xcd_barrier(xbar); }
    }
}

extern "C" void kernel_launch(void* const* d_in, const int* in_sizes, int n_in, void* d_out, int out_size, void* d_ws, size_t ws_size, hipStream_t stream) {
    static int grid = 0;
    if (grid == 0) {
        if (n_in != 39 || ws_size < WS_NEED) { fprintf(stderr, "kernel_launch: unexpected n_in %d / ws_size %zu\n", n_in, ws_size); grid = -1; return; }
        int dev = 0, cus = 0, per_cu = 0;
        hipGetDevice(&dev); hipDeviceGetAttribute(&cus, hipDeviceAttributeMultiprocessorCount, dev);
        if (hipFuncSetAttribute((const void*)mega, hipFuncAttributeMaxDynamicSharedMemorySize, LDS_BYTES) != hipSuccess) { fprintf(stderr, "kernel_launch: hipFuncSetAttribute failed\n"); grid = -1; return; }
        if (hipOccupancyMaxActiveBlocksPerMultiprocessor(&per_cu, (const void*)mega, 512, LDS_BYTES) != hipSuccess || per_cu < 1) per_cu = 1;
        (void)hipGetLastError();
        grid = cus * per_cu; if (grid > 256) grid = 256;
    }
    if (grid < 0) return;
    Args a{};
    for (int i = 0; i < 39; ++i) a.in[i] = (const float*)d_in[i];
    a.out = (float*)d_out; a.ws = (unsigned char*)d_ws;
    (void)hipMemsetAsync((char*)d_ws + OFF_BAR, 0, 16384, stream);
#if SINGLE_LAUNCH
    a.ph_lo = 0; a.ph_hi = 30;
    void* args[] = {&a};
    hipError_t e = hipLaunchCooperativeKernel((const void*)mega, dim3(grid), dim3(512), args, LDS_BYTES, stream);
    if (e != hipSuccess) fprintf(stderr, "cooperative launch failed: %s (grid %d)\n", hipGetErrorString(e), grid);
#else
    for (int p = 0; p < 30; ++p) { a.ph_lo = p; a.ph_hi = p + 1; hipLaunchKernelGGL(mega, dim3(grid), dim3(512), LDS_BYTES, stream, a); }
#endif
}
```
